# Optimizing an MI355X kernel written in HIP

```python
import math
import jax, jax.numpy as jnp
from jax import lax
import numpy as np

D_MODEL = 2048
BATCH = 4
SEQ = 8192
DEPTH = 1

GRID_W = 64
CTX_LEN = 256
RWKV_HEADS = 16
RWKV_HEAD_DIM = 64
RWKV_DIM = RWKV_HEADS * RWKV_HEAD_DIM
DECAY_LORA = 96
AAA_LORA = 96
GATE_LORA = 256
RWKV_COLS = 3 * RWKV_DIM + 2 * DECAY_LORA + 2 * AAA_LORA + GATE_LORA
DIFF_HEADS = 8
DIFF_QK_DIM = 64
DIFF_V_DIM = 2 * DIFF_QK_DIM
DIFF_DIM = DIFF_HEADS * DIFF_V_DIM
DIFF_QK_COLS = DIFF_HEADS * 2 * DIFF_QK_DIM
DIFF_COLS = 2 * DIFF_QK_COLS + DIFF_DIM
DIFF_SCALE = DIFF_QK_DIM ** -0.5
ROPE_THETA = 10000.0
Q_BLOCK = 128
GATE_COLS = 2 * D_MODEL
N_IN = RWKV_COLS + DIFF_COLS + GATE_COLS
N_GROUPS = 4
EXPERTS_PER_GROUP = 8
N_EXPERTS = N_GROUPS * EXPERTS_PER_GROUP
TOP_K = 2
D_EXPERT = 512
MOE_BLOCK = 128
NORM_EPS = 1e-6
SUBLN_EPS = 1e-5
LNX_EPS = 64e-5

kernel_name = "hybrid_rwkv7_diffattn_hmoe_dit"


def rmsnorm(x, g, eps=NORM_EPS):
    xf = x.astype(jnp.float32)
    y = xf * lax.rsqrt(jnp.mean(xf * xf, axis=-1, keepdims=True) + eps)
    return (y * g.astype(jnp.float32)).astype(x.dtype)


def centred_shift(p, mu):
    zero = jnp.zeros_like(p[:, :1])
    prev = jnp.concatenate([zero, p[:, :-1]], axis=1)
    nxt = jnp.concatenate([p[:, 1:], zero], axis=1)
    return p + mu * (0.5 * (prev + nxt) - p)


def rwkv7_scan(s0, r, decay, k, v, kk, a, reverse):
    def step(S, inp):
        r_t, w_t, k_t, v_t, kk_t, a_t = inp
        sa = jnp.einsum('bhvk,bhk->bhv', S, kk_t)
        S = (S * w_t[:, :, None, :] - sa[..., None] * (kk_t * a_t)[:, :, None, :]
             + v_t[..., None] * k_t[:, :, None, :])
        return S, jnp.einsum('bhvk,bhk->bhv', S, r_t)
    xs = tuple(jnp.moveaxis(t, 1, 0) for t in (r, decay, k, v, kk, a))
    s_final, y = lax.scan(step, s0, xs, reverse=reverse)
    return s_final, jnp.moveaxis(y, 0, 1)


def rwkv_branch(p, s0_f, s0_b, w0, w2, a0, a2, g2, k_k, k_a, r_k, lnx_g, lnx_b):
    B_, L, _ = p.shape
    pf = p.astype(jnp.float32)
    C = RWKV_DIM
    r, k, v = pf[..., :C], pf[..., C:2 * C], pf[..., 2 * C:3 * C]
    o = 3 * C
    xw = pf[..., o:o + 2 * DECAY_LORA].reshape(B_, L, 2, DECAY_LORA)
    o += 2 * DECAY_LORA
    xa = pf[..., o:o + 2 * AAA_LORA].reshape(B_, L, 2, AAA_LORA)
    o += 2 * AAA_LORA
    xg = pf[..., o:o + GATE_LORA]
    w_log = -jax.nn.softplus(-(w0 + jnp.einsum('bldr,drc->bldc', jnp.tanh(xw), w2))) - 0.5
    decay = jnp.exp(-jnp.exp(w_log))
    a = jax.nn.sigmoid(a0 + jnp.einsum('bldr,drc->bldc', xa, a2))
    g = jax.nn.sigmoid(xg) @ g2
    heads = lambda t: t.reshape(*t.shape[:-1], RWKV_HEADS, RWKV_HEAD_DIM)
    kk = heads(k * k_k)
    kk = kk * lax.rsqrt(jnp.sum(kk * kk, axis=-1, keepdims=True) + 1e-12)
    kd = k[:, :, None, :] * (1.0 + (a - 1.0) * k_a)
    r_h, v_h, kd_h, a_h, dec_h = heads(r), heads(v), heads(kd), heads(a), heads(decay)
    s_f, y_f = rwkv7_scan(s0_f, r_h, dec_h[:, :, 0], kd_h[:, :, 0], v_h, kk, a_h[:, :, 0], reverse=False)
    s_b, y_b = rwkv7_scan(s0_b, r_h, dec_h[:, :, 1], kd_h[:, :, 1], v_h, kk, a_h[:, :, 1], reverse=True)
    y = y_f + y_b
    mean = jnp.mean(y, axis=-1, keepdims=True)
    var = jnp.mean(jnp.square(y - mean), axis=-1, keepdims=True)
    y = (y - mean) * lax.rsqrt(var + LNX_EPS) * heads(lnx_g) + heads(lnx_b)
    coef = jnp.einsum('blhn,bldhn,hn->blh', r_h, kd_h, r_k)
    y = y + coef[..., None] * v_h
    out = (y.reshape(B_, L, C) * g).astype(p.dtype)
    return out, s_f, s_b


def diff_qkv(p, qn_g, kn_g):
    B_, L, _ = p.shape
    q = p[..., :DIFF_QK_COLS].reshape(B_, L, DIFF_HEADS, 2, DIFF_QK_DIM)
    k = p[..., DIFF_QK_COLS:2 * DIFF_QK_COLS].reshape(B_, L, DIFF_HEADS, 2, DIFF_QK_DIM)
    v = p[..., 2 * DIFF_QK_COLS:].reshape(B_, L, DIFF_HEADS, DIFF_V_DIM)
    return rmsnorm(q, qn_g), rmsnorm(k, kn_g), v


def axial_rope(x, rows, cols):
    half = DIFF_QK_DIM // 2
    inv_freq = ROPE_THETA ** (-jnp.arange(0, half, 2, dtype=jnp.float32) / half)
    def rot(xs, pos):
        ang = pos.astype(jnp.float32)[:, None] * inv_freq
        cos = jnp.cos(ang)[None, :, None, None, :]
        sin = jnp.sin(ang)[None, :, None, None, :]
        x1, x2 = jnp.split(xs.astype(jnp.float32), 2, axis=-1)
        return jnp.concatenate([x1 * cos - x2 * sin, x2 * cos + x1 * sin], axis=-1)
    out = jnp.concatenate([rot(x[..., :half], rows), rot(x[..., half:], cols)], axis=-1)
    return out.astype(x.dtype)


def diff_attn_block(q, k, v, lam):
    s = jnp.einsum('bqhmd,bkhmd->bmhqk', q, k).astype(jnp.float32) * DIFF_SCALE
    p = jax.nn.softmax(s, axis=-1)
    a = p[:, 0] - lam * p[:, 1]
    return jnp.einsum('bhqk,bkhd->bqhd', a.astype(v.dtype), v)


def diff_attn_latent(q, k_all, v_all, lam):
    B_, L = q.shape[:2]
    nb = L // Q_BLOCK
    qb = jnp.moveaxis(q.reshape(B_, nb, Q_BLOCK, *q.shape[2:]), 1, 0)
    o = lax.map(lambda qi: diff_attn_block(qi, k_all, v_all, lam), qb)
    return jnp.moveaxis(o, 0, 1).reshape(B_, L, *o.shape[3:])


def diff_out(o, subln_g, lam_init):
    B_, L = o.shape[:2]
    return (rmsnorm(o, subln_g, SUBLN_EPS) * (1.0 - lam_init)).reshape(B_, L, DIFF_DIM)


def merge_branches(p_gate, y_rwkv, y_diff, w_pa, w_pb, w_out):
    gates = jax.nn.sigmoid(p_gate.reshape(*p_gate.shape[:-1], 2, D_MODEL))
    mixed = gates[..., 0, :] * (y_rwkv @ w_pa) + gates[..., 1, :] * (y_diff @ w_pb)
    return mixed @ w_out


def hierarchical_moe(h, wg, bg, we, be, w1, w3, w2):
    B_, L, D = h.shape
    hf = h.reshape(-1, D)
    N = hf.shape[0]
    g_logits = (hf @ wg + bg).astype(jnp.float32)
    p_group = jax.nn.softmax(g_logits, axis=-1)
    g_top = jnp.argmax(g_logits, axis=-1)
    p_g = jnp.take_along_axis(p_group, g_top[:, None], axis=1)[:, 0]
    e_logits = (hf @ we + be).astype(jnp.float32).reshape(N, N_GROUPS, EXPERTS_PER_GROUP)
    e_sel = jnp.take_along_axis(e_logits, g_top[:, None, None], axis=1)[:, 0]
    top_p, top_i = lax.top_k(jax.nn.softmax(e_sel, axis=-1), TOP_K)
    top_p = top_p / jnp.sum(top_p, axis=-1, keepdims=True)
    gate = p_g[:, None] * top_p
    expert = g_top[:, None] * EXPERTS_PER_GROUP + top_i
    A = N * TOP_K
    flat_e = expert.reshape(-1).astype(jnp.int32)
    flat_tok = jnp.repeat(jnp.arange(N, dtype=jnp.int32), TOP_K)
    flat_w = gate.reshape(-1)
    order = jnp.argsort(flat_e)
    se = flat_e[order]
    counts = jnp.bincount(flat_e, length=N_EXPERTS)
    padded = (counts + MOE_BLOCK - 1) // MOE_BLOCK * MOE_BLOCK
    pend = jnp.cumsum(padded)
    pstart = pend - padded
    start = jnp.cumsum(counts) - counts
    slot = pstart[se] + jnp.arange(A, dtype=jnp.int32) - start[se]
    CAP = (A + MOE_BLOCK - 1) // MOE_BLOCK * MOE_BLOCK + N_EXPERTS * MOE_BLOCK
    n_blocks = CAP // MOE_BLOCK
    slot_tok = jnp.full((CAP,), N, jnp.int32).at[slot].set(flat_tok[order])
    slot_w = jnp.zeros((CAP,), jnp.float32).at[slot].set(flat_w[order])
    blk_expert = jnp.minimum(
        jnp.searchsorted(pend, jnp.arange(n_blocks, dtype=jnp.int32) * MOE_BLOCK, side='right'),
        N_EXPERTS - 1)
    h_pad = jnp.concatenate([hf, jnp.zeros((1, D), hf.dtype)], axis=0)

    def run(args):
        tok, e = args
        xb = h_pad[tok]
        return (jax.nn.silu(xb @ w1[e]) * (xb @ w3[e])) @ w2[e]

    out = lax.map(run, (slot_tok.reshape(n_blocks, MOE_BLOCK), blk_expert)).reshape(CAP, D)
    out = out * slot_w[:, None].astype(out.dtype)
    y = jax.ops.segment_sum(out, slot_tok, num_segments=N + 1)[:N]
    return y.reshape(B_, L, D).astype(h.dtype)


def setup_inputs(seed: int = 0) -> dict:
    key = jax.random.key(seed)
    ks = iter(jax.random.split(key, 40))
    D = D_MODEL
    nrm = lambda shape, scale: jax.random.normal(next(ks), shape, jnp.float32) * scale
    uni = lambda shape, lo, hi: jax.random.uniform(next(ks), shape, jnp.float32, lo, hi)
    return {
        "x": nrm((BATCH, SEQ, D), 1.0),
        "c": nrm((BATCH, D), 1.0),
        "ctx": nrm((BATCH, CTX_LEN, D), 1.0),
        "c_ctx": nrm((D,), 1.0),
        "ada_w": nrm((DEPTH, D, 6 * D), 0.3 * D ** -0.5),
        "ada_b": nrm((DEPTH, 6 * D), 0.02),
        "norm1_g": 1.0 + nrm((DEPTH, D), 0.02),
        "norm2_g": 1.0 + nrm((DEPTH, D), 0.02),
        "w_in": nrm((DEPTH, D, N_IN), D ** -0.5),
        "shift_mu": uni((DEPTH, RWKV_COLS), 0.0, 1.0),
        "rwkv_w0": uni((DEPTH, 2, RWKV_DIM), -6.0, -1.0),
        "rwkv_w2": nrm((DEPTH, 2, DECAY_LORA, RWKV_DIM), 0.5 * DECAY_LORA ** -0.5),
        "rwkv_a0": nrm((DEPTH, 2, RWKV_DIM), 0.1),
        "rwkv_a2": nrm((DEPTH, 2, AAA_LORA, RWKV_DIM), 0.5 * AAA_LORA ** -0.5),
        "rwkv_g2": nrm((DEPTH, GATE_LORA, RWKV_DIM), GATE_LORA ** -0.5),
        "rwkv_k_k": 0.85 + nrm((DEPTH, RWKV_DIM), 0.02),
        "rwkv_k_a": 1.0 + nrm((DEPTH, RWKV_DIM), 0.02),
        "rwkv_r_k": nrm((DEPTH, RWKV_HEADS, RWKV_HEAD_DIM), 0.1),
        "rwkv_lnx_g": 1.0 + nrm((DEPTH, RWKV_DIM), 0.02),
        "rwkv_lnx_b": nrm((DEPTH, RWKV_DIM), 0.02),
        "qn_g": 1.0 + nrm((DEPTH, DIFF_QK_DIM), 0.02),
        "kn_g": 1.0 + nrm((DEPTH, DIFF_QK_DIM), 0.02),
        "diff_lambda": nrm((DEPTH, 4, DIFF_QK_DIM), 0.1),
        "subln_g": 1.0 + nrm((DEPTH, DIFF_V_DIM), 0.02),
        "w_pa": nrm((DEPTH, RWKV_DIM, D), RWKV_DIM ** -0.5),
        "w_pb": nrm((DEPTH, DIFF_DIM, D), DIFF_DIM ** -0.5),
        "w_out": nrm((DEPTH, D, D), D ** -0.5),
        "router_g_w": nrm((DEPTH, D, N_GROUPS), D ** -0.5),
        "router_g_b": nrm((DEPTH, N_GROUPS), 0.01),
        "router_e_w": nrm((DEPTH, D, N_EXPERTS), D ** -0.5),
        "router_e_b": nrm((DEPTH, N_EXPERTS), 0.01),
        "exp_w1": nrm((DEPTH, N_EXPERTS, D, D_EXPERT), D ** -0.5),
        "exp_w3": nrm((DEPTH, N_EXPERTS, D, D_EXPERT), D ** -0.5),
        "exp_w2": nrm((DEPTH, N_EXPERTS, D_EXPERT, D), D_EXPERT ** -0.5),
    }


def reference(x, c, ctx, c_ctx, ada_w, ada_b, norm1_g, norm2_g, w_in, shift_mu,
              rwkv_w0, rwkv_w2, rwkv_a0, rwkv_a2, rwkv_g2, rwkv_k_k, rwkv_k_a, rwkv_r_k,
              rwkv_lnx_g, rwkv_lnx_b, qn_g, kn_g, diff_lambda, subln_g, w_pa, w_pb, w_out,
              router_g_w, router_g_b, router_e_w, router_e_b, exp_w1, exp_w3, exp_w2):
    B_, L, _ = x.shape
    ROWS = L // GRID_W
    rows = jnp.repeat(jnp.arange(ROWS, dtype=jnp.int32), GRID_W)
    cols = jnp.tile(jnp.arange(GRID_W, dtype=jnp.int32), ROWS)
    o_diff = RWKV_COLS
    o_gate = RWKV_COLS + DIFF_COLS
    cx = ctx
    for l in range(DEPTH):
        lam_init = 0.8 - 0.6 * math.exp(-0.3 * l)
        lv = diff_lambda[l].astype(jnp.float32)
        lam = jnp.exp(jnp.sum(lv[0] * lv[1])) - jnp.exp(jnp.sum(lv[2] * lv[3])) + lam_init
        mod_x = jax.nn.silu(c) @ ada_w[l] + ada_b[l]
        mod_c = jax.nn.silu(c_ctx) @ ada_w[l] + ada_b[l]
        sh1, sc1, gt1, sh2, sc2, gt2 = jnp.split(mod_x[:, None, :], 6, axis=-1)
        csh1, csc1, cgt1, csh2, csc2, cgt2 = jnp.split(mod_c, 6, axis=-1)
        hx = rmsnorm(x, norm1_g[l]) * (1.0 + sc1) + sh1
        hc = rmsnorm(cx, norm1_g[l]) * (1.0 + csc1) + csh1
        px = hx @ w_in[l]
        pc = hc @ w_in[l]
        rwkv_p = (rwkv_w0[l], rwkv_w2[l], rwkv_a0[l], rwkv_a2[l], rwkv_g2[l], rwkv_k_k[l],
                  rwkv_k_a[l], rwkv_r_k[l], rwkv_lnx_g[l], rwkv_lnx_b[l])
        s0 = jnp.zeros((B_, RWKV_HEADS, RWKV_HEAD_DIM, RWKV_HEAD_DIM), jnp.float32)
        yc_r, s_f, s_b = rwkv_branch(centred_shift(pc[..., :RWKV_COLS], shift_mu[l]), s0, s0, *rwkv_p)
        yx_r, _, _ = rwkv_branch(centred_shift(px[..., :RWKV_COLS], shift_mu[l]), s_f, s_b, *rwkv_p)
        qx, kx, vx = diff_qkv(px[..., o_diff:o_gate], qn_g[l], kn_g[l])
        qx = axial_rope(qx, rows, cols)
        kx = axial_rope(kx, rows, cols)
        qc, kc, vc = diff_qkv(pc[..., o_diff:o_gate], qn_g[l], kn_g[l])
        k_all = jnp.concatenate([kc, kx], axis=1)
        v_all = jnp.concatenate([vc, vx], axis=1)
        yx_d = diff_out(diff_attn_latent(qx, k_all, v_all, lam), subln_g[l], lam_init)
        mix_x = merge_branches(px[..., o_gate:], yx_r, yx_d, w_pa[l], w_pb[l], w_out[l])
        x_new = x + gt1 * mix_x
        moe_p = (router_g_w[l], router_g_b[l], router_e_w[l], router_e_b[l], exp_w1[l], exp_w3[l], exp_w2[l])
        h2 = rmsnorm(x_new, norm2_g[l]) * (1.0 + sc2) + sh2
        x_new = x_new + gt2 * hierarchical_moe(h2, *moe_p)
        if l < DEPTH - 1:
            yc_d = diff_out(diff_attn_block(qc, kc, vc, lam), subln_g[l], lam_init)
            mix_c = merge_branches(pc[..., o_gate:], yc_r, yc_d, w_pa[l], w_pb[l], w_out[l])
            cx = cx + cgt1 * mix_c
            hc2 = rmsnorm(cx, norm2_g[l]) * (1.0 + csc2) + csh2
            cx = cx + cgt2 * hierarchical_moe(hc2, *moe_p)
        x = x_new
    return x
```

```cpp
#include <hip/hip_runtime.h>
#include <cstdio>
#include <cstdint>

#ifndef MK_PER_PHASE
#define MK_PER_PHASE 0
#endif

#define GAS __attribute__((address_space(1)))
#define LAS __attribute__((address_space(3)))
typedef unsigned short bf16;
typedef unsigned v4u __attribute__((ext_vector_type(4)));
typedef unsigned v2u __attribute__((ext_vector_type(2)));
typedef float f32x4 __attribute__((ext_vector_type(4)));
typedef float f32x2 __attribute__((ext_vector_type(2)));
typedef float f32x16 __attribute__((ext_vector_type(16)));
typedef short bf16x8 __attribute__((ext_vector_type(8)));
typedef GAS unsigned gu32;
#define RLX_AGENT __ATOMIC_RELAXED, __HIP_MEMORY_SCOPE_AGENT
#define LDS_WAIT() asm volatile("s_waitcnt lgkmcnt(0)" ::: "memory")
#define VM_WAIT() asm volatile("s_waitcnt vmcnt(0)" ::: "memory")

constexpr int D = 2048, NB = 4, T = 8192, CTXL = 256, TE = T + CTXL;
constexpr int ME = NB * TE, ML = NB * T;
constexpr int RC = 1024, RH = 16, RN = 64;
constexpr int NIN = 10880, RWKV_COLS = 3712;
constexpr int P1LD = 5888, PQ = 3840, PK = 4864;
constexpr int XLLD = 768;
constexpr int NE = 32, DE = 512, CAPB = 288;
constexpr float C2 = 0.125f * 1.4426950408889634f;

constexpr size_t MiB = 1u << 20;
constexpr size_t WS_CTL = 0, CTL_ZERO_BYTES = 512 * 1024;
constexpr size_t WS_SMALL = 256 * 1024;
constexpr size_t WS_LW = 1 * MiB;
constexpr size_t WS_HX = 4 * MiB;
constexpr size_t OUT_YF = 192 * MiB;
constexpr size_t WS_YB = 844 * MiB;
constexpr size_t WS_W1T = 136 * MiB, WS_WVT = 159 * MiB;
constexpr size_t WS_XL = 136 * MiB;
constexpr size_t WS_YD = 136 * MiB;
constexpr size_t WS_P1 = 200 * MiB;
constexpr size_t WS_VT = 580 * MiB;
constexpr size_t WS_LO = 646 * MiB;
constexpr size_t WS_G = 910 * MiB;
constexpr size_t WS_END1 = 976 * MiB;
constexpr size_t WS_WGT = 976 * MiB, WS_WPA = 992 * MiB, WS_WPB = 996 * MiB, WS_WOUT = 1000 * MiB;
constexpr size_t WS_HX2 = 646 * MiB;
constexpr size_t WS_GATE = 360 * MiB;
constexpr size_t WS_MIX = 616 * MiB;
constexpr size_t OUT_EW13 = 0, OUT_EW2 = 128 * MiB;
constexpr size_t WS_XN = 744 * MiB;
constexpr size_t WS_H2 = 4 * MiB;
constexpr size_t WS_XG = 200 * MiB;
constexpr size_t WS_HM = 488 * MiB;
constexpr size_t WS_TOK = 560 * MiB;
constexpr size_t WS_GOFF = 562 * MiB;
constexpr size_t WS_BON = 1008 * MiB;
constexpr size_t WS_NEED = 1012 * MiB;
constexpr int SM_MOD = 0;
constexpr int SM_ROPE = 5 * 12288;
constexpr int SM_MISC = SM_ROPE + 128 * 32;
constexpr int SM_WRT = SM_MISC + 64;
constexpr int SM_WET = SM_WRT + 36 * 2048;
constexpr int CW_BAR = 4096;
constexpr int CW_ATT = 8192;
constexpr int CW_MODPUB = 24576 + 64 * 301;
constexpr int CW_CNT = 16384, CNT_STRIDE = 64;

constexpr int RING_BYTES = 131072, LDS_BYTES = 147456, LDSCTL_OFF = LDS_BYTES - 4096, MISC_OFF = LDSCTL_OFF + 2048;

__device__ __forceinline__ float bf2f(unsigned b) { return __uint_as_float(b << 16); }
typedef __bf16 bf16x2_t __attribute__((ext_vector_type(2)));
__device__ __forceinline__ unsigned cvt_pk_bf16(float lo, float hi) { const f32x2 v = {lo, hi}; const bf16x2_t b = __builtin_convertvector(v, bf16x2_t); return __builtin_bit_cast(unsigned, b); }
__device__ __forceinline__ unsigned pk_f16(float lo, float hi) { _Float16 a = (_Float16)lo, b = (_Float16)hi; return (unsigned)__builtin_bit_cast(unsigned short, a) | ((unsigned)__builtin_bit_cast(unsigned short, b) << 16); }
__device__ __forceinline__ float f16lo(unsigned w) { return (float)__builtin_bit_cast(_Float16, (unsigned short)(w & 0xffffu)); }
__device__ __forceinline__ float f16hi(unsigned w) { return (float)__builtin_bit_cast(_Float16, (unsigned short)(w >> 16)); }
__device__ __forceinline__ float sigmoidf_(float x) { return __builtin_amdgcn_rcpf(1.0f + __expf(-x)); }
__device__ __forceinline__ float wave_sum(float v) {
#pragma unroll
    for (int o = 1; o < 64; o <<= 1) v += __shfl_xor(v, o);
    return v;
}
__device__ __forceinline__ float red16(float v) {
    v += __builtin_bit_cast(float, __builtin_amdgcn_update_dpp(0, __builtin_bit_cast(int, v), 0xB1, 0xF, 0xF, true));
    v += __builtin_bit_cast(float, __builtin_amdgcn_update_dpp(0, __builtin_bit_cast(int, v), 0x4E, 0xF, 0xF, true));
    v += __builtin_bit_cast(float, __builtin_amdgcn_update_dpp(0, __builtin_bit_cast(int, v), 0x141, 0xF, 0xF, true));
    v += __builtin_bit_cast(float, __builtin_amdgcn_update_dpp(0, __builtin_bit_cast(int, v), 0x140, 0xF, 0xF, true));
    return v;
}

namespace pg8 {
#define PG8_LAS __attribute__((address_space(3)))
typedef unsigned short bf16_t;
constexpr int BM = 256, BK = 64, HALF = 128, HTB = HALF * BK * 2, STAGE_BYTES = 8 * HTB;
__host__ __device__ __forceinline__ int lds_byte(int r, int c) { const int st = (r >> 4) * 2 + (c >> 5), rr = r & 15, cc = c & 31, ob = rr * 64 + cc * 2; return st * 1024 + (ob ^ (((ob >> 9) & 1) << 5)); }
__host__ __device__ __forceinline__ void stage_rc(int b, int& R, int& C) { const int st = b / 1024, sb = b % 1024, swz = sb ^ (((sb >> 9) & 1) << 5); R = (st >> 1) * 16 + swz / 64; C = (st & 1) * 32 + (swz % 64) / 2; }
__host__ __device__ __forceinline__ int perm32(int rho) { const int n = rho >> 4, i = rho & 15; return 8 * (i >> 2) + 4 * n + (i & 3); }
struct Unit { int kind, pm, pn; };
__device__ __forceinline__ void tile_order(int L, int nM, int nN, int& pm, int& pn) {
    const int nwg = nM * nN; int wgid = L;
    { const int q = nwg / 8, r = nwg % 8, xcd = wgid % 8, off = wgid / 8; wgid = (xcd < r ? xcd * (q + 1) : r * (q + 1) + (xcd - r) * q) + off; }
    const int nig = 8 * nN, gid = wgid / nig, fm = gid * 8, gsz = (nM - fm) < 8 ? (nM - fm) : 8;
    pm = fm + ((wgid % nig) % gsz); pn = (wgid % nig) / gsz;
}
template <class Epi, class Sched, bool GATHER = false>
__device__ __forceinline__ void gemm_phase(PG8_LAS unsigned char* lds, const int lda, const int ldb, const Sched& S, const Epi& E, const unsigned* gtab = nullptr) {
    const int tid = threadIdx.x, wid = __builtin_amdgcn_readfirstlane(tid >> 6), lane = tid & 63, wr = wid >> 2, wc = wid & 3, fr = lane & 15, fq = lane >> 4;
    unsigned voffA[2], voffA1[2], nvA[2], nvA1[2], voffB[2]; int gR[2], gC[2];
#pragma unroll
    for (int i = 0; i < 2; ++i) { int R, C; stage_rc(tid * 16 + i * 8192, R, C); const int Rb = (R & ~31) + perm32(R & 31); gR[i] = R; gC[i] = C * 2;
        voffA[i] = (unsigned)(R * lda + C) * 2u; voffA1[i] = voffA[i] + (unsigned)(HALF * lda * 2); nvA[i] = voffA[i]; nvA1[i] = voffA1[i]; voffB[i] = (unsigned)(Rb * ldb + C) * 2u; }
    const size_t kstep = (size_t)(BK * 2);
    const size_t hstepB = (size_t)HALF * ldb * 2;
    const unsigned ldsw = (unsigned)wid * 1024u;
    const int aoff = lds_byte(wr * 64 + fr, fq * 8), boff = lds_byte(wc * 32 + fr, fq * 8);
#define PG8_SA(b, h) (((b) * 2 + (h)) * HTB)
#define PG8_SB(b, h) ((4 + (b) * 2 + (h)) * HTB)
#define PG8_STAGE(bufoff, gbase, voff) do { _Pragma("unroll") for (int _i = 0; _i < 2; ++_i) \
        __builtin_amdgcn_global_load_lds((const unsigned*)((const char*)(gbase) + (voff)[_i]), (PG8_LAS unsigned*)(lds + (bufoff) + ldsw + _i * 8192), 16, 0, 0); } while (0)
#define PG8_LDA(dst, b, h) do { _Pragma("unroll") for (int m = 0; m < 4; ++m) _Pragma("unroll") for (int k = 0; k < 2; ++k) dst[m][k] = *(const PG8_LAS bf16x8*)(lds + PG8_SA(b, h) + aoff + m * 2048 + k * 1024); } while (0)
#define PG8_LDB(dst, b, h) do { _Pragma("unroll") for (int n = 0; n < 2; ++n) _Pragma("unroll") for (int k = 0; k < 2; ++k) dst[n][k] = *(const PG8_LAS bf16x8*)(lds + PG8_SB(b, h) + boff + n * 2048 + k * 1024); } while (0)
#define PG8_MMA(ai, bj, At, Bt) do { __builtin_amdgcn_s_setprio(1); _Pragma("unroll") for (int m = 0; m < 4; ++m) _Pragma("unroll") for (int n = 0; n < 2; ++n) _Pragma("unroll") for (int k = 0; k < 2; ++k) \
        acc[ai][bj][m][n] = __builtin_amdgcn_mfma_f32_16x16x32_bf16(Bt[n][k], At[m][k], acc[ai][bj][m][n], 0, 0, 0); __builtin_amdgcn_s_setprio(0); } while (0)
#define PG8_WAIT_V(n) asm volatile("s_waitcnt vmcnt(" #n ")" ::: "memory")
#define PG8_WAIT_L(n) asm volatile("s_waitcnt lgkmcnt(" #n ")" ::: "memory")
#define PG8_BAR __builtin_amdgcn_s_barrier()
#define PG8_SCHED __builtin_amdgcn_sched_barrier(0)
    Unit cur, nxt; int ui = 0;
    if (!S.next(0, cur)) return;
    f32x4 acc[2][2][4][2];
#pragma unroll
    for (int a = 0; a < 2; ++a)
#pragma unroll
        for (int b = 0; b < 2; ++b)
#pragma unroll
            for (int m = 0; m < 4; ++m)
#pragma unroll
                for (int n = 0; n < 2; ++n) acc[a][b][m][n] = (f32x4){0.f, 0.f, 0.f, 0.f};
    bf16x8 At[4][2], B0[2][2], B1[2][2];
    const char* cA = S.a_ptr(cur); const char* cB = S.b_ptr(cur); int nt = S.nt(cur);
    if constexpr (GATHER) {
#pragma unroll
        for (int i = 0; i < 2; ++i) { voffA[i] = S.goff(cur, gR[i]) + (unsigned)gC[i]; voffA1[i] = S.goff(cur, HALF + gR[i]) + (unsigned)gC[i]; } }
    PG8_STAGE(PG8_SB(0, 0), cB, voffB); PG8_STAGE(PG8_SB(0, 1), cB + hstepB, voffB); PG8_STAGE(PG8_SA(0, 0), cA, voffA); PG8_STAGE(PG8_SA(0, 1), cA, voffA1);
    if (wr == 1) PG8_BAR;
    PG8_WAIT_V(2); PG8_BAR;
    PG8_STAGE(PG8_SB(1, 0), cB + kstep, voffB); PG8_STAGE(PG8_SA(1, 0), cA + kstep, voffA); PG8_STAGE(PG8_SB(1, 1), cB + hstepB + kstep, voffB);
    PG8_WAIT_V(6); PG8_BAR;
    for (;;) {
        const bool has_next = S.next(ui + 1, nxt);
        const char* nA = has_next ? S.a_ptr(nxt) : cA; const char* nB = has_next ? S.b_ptr(nxt) : cB;
        if constexpr (GATHER) {
#pragma unroll
            for (int i = 0; i < 2; ++i) { nvA[i] = voffA[i]; nvA1[i] = voffA1[i]; }
            if (has_next) {
#pragma unroll
                for (int i = 0; i < 2; ++i) { nvA[i] = S.goff(nxt, gR[i]) + (unsigned)gC[i]; nvA1[i] = S.goff(nxt, HALF + gR[i]) + (unsigned)gC[i]; } } }
        for (int t = 0; t < nt; t += 2) {
            const bool last = (t == nt - 2);
            const char* a1 = cA + (size_t)(t + 1) * kstep;
            const char* a2 = last ? nA : cA + (size_t)(t + 2) * kstep; const char* b2 = last ? nB : cB + (size_t)(t + 2) * kstep;
            const char* a3 = a2 + kstep; const char* b3 = b2 + kstep;
            unsigned va2[2], va21[2];
#pragma unroll
            for (int i = 0; i < 2; ++i) { va2[i] = (GATHER && last) ? nvA[i] : voffA[i]; va21[i] = (GATHER && last) ? nvA1[i] : voffA1[i]; }
            PG8_LDB(B0, 0, 0); PG8_LDB(B1, 0, 1); PG8_SCHED; PG8_LDA(At, 0, 0); PG8_STAGE(PG8_SA(1, 1), a1, voffA1);
            PG8_WAIT_V(8); PG8_WAIT_L(0); PG8_BAR; PG8_MMA(0, 0, At, B0); PG8_MMA(0, 1, At, B1); PG8_BAR; PG8_SCHED;
            PG8_LDA(At, 0, 1); PG8_STAGE(PG8_SB(0, 0), b2, voffB); PG8_STAGE(PG8_SB(0, 1), b2 + hstepB, voffB); PG8_STAGE(PG8_SA(0, 0), a2, va2);
            PG8_WAIT_V(8); PG8_WAIT_L(0); PG8_BAR; PG8_MMA(1, 0, At, B0); PG8_MMA(1, 1, At, B1); PG8_BAR; PG8_SCHED;
            PG8_LDB(B0, 1, 0); PG8_LDB(B1, 1, 1); PG8_SCHED; PG8_LDA(At, 1, 0); PG8_STAGE(PG8_SA(0, 1), a2, va21);
            PG8_WAIT_V(8); PG8_WAIT_L(0); PG8_BAR; PG8_MMA(0, 0, At, B0); PG8_MMA(0, 1, At, B1); PG8_BAR; PG8_SCHED;
            PG8_LDA(At, 1, 1); PG8_STAGE(PG8_SB(1, 0), b3, voffB); PG8_STAGE(PG8_SB(1, 1), b3 + hstepB, voffB); PG8_STAGE(PG8_SA(1, 0), a3, va2);
            PG8_WAIT_V(8); PG8_WAIT_L(0); PG8_BAR; PG8_MMA(1, 0, At, B0); PG8_MMA(1, 1, At, B1); PG8_BAR; PG8_SCHED;
        }
        if (wr == 0) PG8_BAR;
        E(acc, cur, wr, wc, fr, fq);
        if (!has_next) break;
        if (!S.keep(cur)) {
#pragma unroll
        for (int a = 0; a < 2; ++a)
#pragma unroll
            for (int b = 0; b < 2; ++b)
#pragma unroll
                for (int m = 0; m < 4; ++m)
#pragma unroll
                    for (int n = 0; n < 2; ++n) acc[a][b][m][n] = (f32x4){0.f, 0.f, 0.f, 0.f};
        }
        cur = nxt; cA = nA; cB = nB; nt = S.nt(cur); ++ui;
        if (GATHER) {
#pragma unroll
            for (int i = 0; i < 2; ++i) { voffA[i] = nvA[i]; voffA1[i] = nvA1[i]; } }
        if (wr == 1) PG8_BAR;
    }
    PG8_WAIT_V(0);
    PG8_BAR;
#undef PG8_SA
#undef PG8_SB
#undef PG8_STAGE
#undef PG8_LDA
#undef PG8_LDB
#undef PG8_MMA
#undef PG8_WAIT_V
#undef PG8_WAIT_L
#undef PG8_BAR
#undef PG8_SCHED
}
}
using pg8::Unit;

#define XB_TMO      128
#define XB_XCNT(j)  (256  + 64 * (j))
#define XB_XSUB(j)  (1280 + 64 * (j))
#define XB_XGEN(j)  (2304 + 64 * (j))
#define XB_TOP      3328
#define XB_TOPGEN   3392
#define XCD_BAR_WORDS 3456
#define XB_SPIN_CAP (1u << 22)
__device__ __forceinline__ unsigned xb_ld(unsigned* p)              { return __hip_atomic_load(p, __ATOMIC_RELAXED, __HIP_MEMORY_SCOPE_AGENT); }
__device__ __forceinline__ unsigned xb_add(unsigned* p, unsigned v) { return __hip_atomic_fetch_add(p, v, __ATOMIC_RELAXED, __HIP_MEMORY_SCOPE_AGENT); }
__device__ __forceinline__ unsigned xb_xcc_id() { return (unsigned)__builtin_amdgcn_s_getreg((3 << 11) | 20) & 0xFu; }
#define XB_SPIN(cond, bar) do { unsigned _sp = 0; while (cond) { __builtin_amdgcn_s_sleep(1); \
    if ((++_sp & 255u) == 0u) { if (xb_ld(&(bar)[XB_TMO])) break; if (_sp > XB_SPIN_CAP) { atomicAdd(&(bar)[XB_TMO], 1u); break; } } } } while (0)
struct XcdBarrier { unsigned* bar; unsigned x; volatile LAS unsigned* st; };
__device__ __forceinline__ XcdBarrier xcd_barrier_post(unsigned* bar, volatile LAS unsigned* st) {
    XcdBarrier b; b.bar = bar; b.x = xb_xcc_id(); b.st = st;
    if (threadIdx.x == 0) (void)xb_add(&bar[XB_XCNT(b.x)], 1u);
    return b;
}
__device__ __forceinline__ void xcd_barrier_complete(unsigned* bar, unsigned x, unsigned& nloc, unsigned& nx) {
    const unsigned G = gridDim.x * gridDim.y * gridDim.z;
    unsigned sum, cnt, mine, sp = 0u;
    for (;;) {
        sum = 0u; cnt = 0u; mine = 0u;
#pragma unroll
        for (unsigned j = 0; j < 16; ++j) { const unsigned c = xb_ld(&bar[XB_XCNT(j)]); sum += c; cnt += (c > 0u) ? 1u : 0u; mine = (j == x) ? c : mine; }
        if (sum == G) break;
        __builtin_amdgcn_s_sleep(1);
        if ((++sp & 255u) == 0u) { if (xb_ld(&bar[XB_TMO])) break; if (sp > XB_SPIN_CAP) { atomicAdd(&bar[XB_TMO], 1u); break; } }
    }
    nloc = mine > 0u ? mine : 1u; nx = cnt > 0u ? cnt : 1u;
}
__device__ __forceinline__ void xcd_barrier(const XcdBarrier& b) {
    asm volatile("s_waitcnt vmcnt(0)" ::: "memory");
    __syncthreads();
    if (threadIdx.x == 0) {
        unsigned* bar = b.bar;
        __builtin_amdgcn_s_waitcnt(0);
        unsigned nloc = b.st[0], nx = b.st[1];
        if (nloc == 0u) { xcd_barrier_complete(bar, b.x, nloc, nx); b.st[0] = nloc; b.st[1] = nx; }
        const unsigned old = xb_add(&bar[XB_XSUB(b.x)], 1u);
        const unsigned gen = old / nloc;
        if (old + 1u == (gen + 1u) * nloc) {
            __builtin_amdgcn_fence(__ATOMIC_RELEASE, "agent");
            asm volatile("s_waitcnt vmcnt(0)" ::: "memory");
            (void)xb_add(&bar[XB_TOP], 1u);
        }
        XB_SPIN(xb_ld(&bar[XB_TOP]) < (gen + 1u) * nx, bar);
        __builtin_amdgcn_fence(__ATOMIC_ACQUIRE, "agent");
        asm volatile("s_waitcnt vmcnt(0)" ::: "memory");
    }
    __syncthreads();
}

struct Args { const float* in[34]; float* out; unsigned char* ws; int ph_lo, ph_hi; };
struct Frame {
    LAS unsigned char* lds;
    unsigned char* ws;
    int tid, lane, wave, G, bid;
    int gw, ngw;
};

__device__ __forceinline__ void tr_item(const float* W, int Nsrc, int n0s, int k0, int kvalid, bf16* WT, int ldk, int drow, LAS float* scr, int lane) {
#pragma unroll 8
    for (int i = 0; i < 32; ++i) { const int kk = 2 * i + (lane >> 5); const int k = k0 + kk;
        scr[kk * 33 + (lane & 31)] = (k < kvalid) ? W[(size_t)k * Nsrc + n0s + (lane & 31)] : 0.f; }
    LDS_WAIT(); asm volatile("" ::: "memory");
    const int c = lane & 7;
#pragma unroll
    for (int j = 0; j < 4; ++j) { const int n = (lane >> 3) + 8 * j; const LAS float* s = scr + (8 * c) * 33 + n;
        v4u o; o.x = cvt_pk_bf16(s[0 * 33], s[1 * 33]); o.y = cvt_pk_bf16(s[2 * 33], s[3 * 33]); o.z = cvt_pk_bf16(s[4 * 33], s[5 * 33]); o.w = cvt_pk_bf16(s[6 * 33], s[7 * 33]);
        *(GAS v4u*)(WT + (size_t)(drow + n) * ldk + k0 + 8 * c) = o; }
    LDS_WAIT(); asm volatile("" ::: "memory");
}
__device__ __forceinline__ void tr_job(int r, const float* W, int Nsrc, int c0, int ncols, int K, bf16* WT, int ldk, int drow0, LAS float* scr, int lane) {
    const int nblk = ncols / 32, kb = r / nblk, nb = r % nblk;
    tr_item(W, Nsrc, c0 + 32 * nb, 64 * kb, K, WT, ldk, drow0 + 32 * nb, scr, lane);
}

__device__ __forceinline__ void tr_item64(const float* W, int Nsrc, int n0s, int k0, bf16* WT, int ldk, int drow, LAS float* scr, int lane) {
    f32x4 v[16];
    const float* src = W + (size_t)(k0 + (lane >> 4)) * Nsrc + n0s + 4 * (lane & 15);
#pragma unroll
    for (int it = 0; it < 16; ++it) v[it] = *(const GAS f32x4*)(src + (size_t)(4 * it) * Nsrc);
    LAS float* wp = scr + (4 * (lane & 15)) * 65 + (lane >> 4);
#pragma unroll
    for (int it = 0; it < 16; ++it) { wp[4 * it] = v[it].x; wp[65 + 4 * it] = v[it].y; wp[130 + 4 * it] = v[it].z; wp[195 + 4 * it] = v[it].w; }
    LDS_WAIT(); asm volatile("" ::: "memory");
    const int c = lane & 7;
#pragma unroll
    for (int j = 0; j < 8; ++j) { const int n = (lane >> 3) + 8 * j; const LAS float* sp = scr + n * 65 + 8 * c;
        v4u o; o.x = cvt_pk_bf16(sp[0], sp[1]); o.y = cvt_pk_bf16(sp[2], sp[3]); o.z = cvt_pk_bf16(sp[4], sp[5]); o.w = cvt_pk_bf16(sp[6], sp[7]);
        *(GAS v4u*)(WT + (size_t)(drow + n) * ldk + k0 + 8 * c) = o; }
    LDS_WAIT(); asm volatile("" ::: "memory");
}
__device__ __forceinline__ void tr_job64(int r, const float* W, int Nsrc, int c0, int ncols, bf16* WT, int ldk, int drow0, LAS float* scr, int lane) {
    const int nblk = ncols / 64, kb = r / nblk, nb = r % nblk;
    tr_item64(W, Nsrc, c0 + 64 * nb, 64 * kb, WT, ldk, drow0 + 64 * nb, scr, lane);
}

__device__ __forceinline__ void phase_prologue(const Frame& F, const Args& A) {
    float* sm = (float*)(F.ws + WS_SMALL);
    {
        LAS float* sl = (LAS float*)F.lds;
        for (int i = F.tid; i < 5 * 2048; i += 512) { const int r = i >> 11, k = i & 2047; const float v = (r < 4) ? A.in[1][r * 2048 + k] : A.in[3][k]; sl[i] = v * sigmoidf_(v); }
        __syncthreads();
        for (int it = F.gw; it < 192 * 16; it += F.ngw) {
            const int cgp = it >> 4, kc = it & 15, n = cgp * 64 + F.lane, k0 = kc * 128;
            const float* W = A.in[4] + (size_t)k0 * 12288 + n;
            float a0 = 0.f, a1 = 0.f, a2 = 0.f, a3 = 0.f, a4 = 0.f;
#pragma unroll 16
            for (int k = 0; k < 128; ++k) { const float w = W[(size_t)k * 12288]; const int kk = k0 + k;
                a0 += sl[kk] * w; a1 += sl[2048 + kk] * w; a2 += sl[4096 + kk] * w; a3 += sl[6144 + kk] * w; a4 += sl[8192 + kk] * w; }
            const float bb = kc == 0 ? A.in[5][n] : 0.f;
            atomicAdd(sm + SM_MOD + n, a0 + bb); atomicAdd(sm + SM_MOD + 12288 + n, a1 + bb); atomicAdd(sm + SM_MOD + 2 * 12288 + n, a2 + bb);
            atomicAdd(sm + SM_MOD + 3 * 12288 + n, a3 + bb); atomicAdd(sm + SM_MOD + 4 * 12288 + n, a4 + bb);
        }
        asm volatile("s_waitcnt vmcnt(0)" ::: "memory");
        __syncthreads();
        if (F.tid == 0) { __builtin_amdgcn_fence(__ATOMIC_RELEASE, "agent"); asm volatile("s_waitcnt vmcnt(0)" ::: "memory");
            __hip_atomic_fetch_add((unsigned*)(F.ws + WS_CTL) + CW_MODPUB, 1u, __ATOMIC_RELAXED, __HIP_MEMORY_SCOPE_AGENT); }
    }
    if (F.bid == 24) {
        for (int i = F.tid; i < 128 * 16; i += 512) { const int pos = i >> 4, fi = i & 15;
            const float invf = powf(10000.0f, -(float)fi / 16.0f); const float angf = (float)pos * invf;
            double a = (double)angf; const double twopi = 6.283185307179586476925; a -= twopi * rint(a / twopi);
            const double a2 = a * a; double s = 0.0, c = 0.0;
            { double term = a; s = a; for (int n = 1; n <= 12; ++n) { term *= -a2 / (double)((2 * n) * (2 * n + 1)); s += term; } }
            { double term = 1.0; c = 1.0; for (int n = 1; n <= 12; ++n) { term *= -a2 / (double)((2 * n - 1) * (2 * n)); c += term; } }
            sm[SM_ROPE + 2 * i] = (float)c; sm[SM_ROPE + 2 * i + 1] = (float)s; }
        if (F.wave == 0) {
            const float* lv = A.in[22];
            const float v0 = lv[F.lane] * lv[64 + F.lane], v1 = lv[128 + F.lane] * lv[192 + F.lane];
            const float s0 = wave_sum(v0), s1 = wave_sum(v1);
            float gq = fabsf(A.in[20][F.lane]), gk = fabsf(A.in[21][F.lane]);
#pragma unroll
            for (int o = 1; o < 64; o <<= 1) { gq = fmaxf(gq, __shfl_xor(gq, o)); gk = fmaxf(gk, __shfl_xor(gk, o)); }
            if (F.lane == 0) { sm[SM_MISC + 0] = expf(s0) - expf(s1) + 0.2f; sm[SM_MISC + 1] = C2 * 64.0f * gq * gk * 1.02f + 0.25f; }
        }
    }
    if (F.bid >= 25 && F.bid < 29) {
        for (int i = (F.bid - 25) * 512 + F.tid; i < 36 * 2048; i += 4 * 512) { const int n = i >> 11, k = i & 2047;
            sm[SM_WRT + i] = (n < 4) ? A.in[27][k * 4 + n] : A.in[29][k * 32 + (n - 4)];
            if (n >= 4) ((_Float16*)(sm + SM_WET))[(n - 4) * 2048 + k] = (_Float16)A.in[29][k * 32 + (n - 4)]; }
    }
    __syncthreads();
    LAS float* scr = (LAS float*)(F.lds + F.wave * 16640);
    bf16* W1T = (bf16*)(F.ws + WS_W1T); bf16* WVT = (bf16*)(F.ws + WS_WVT); bf16* LW = (bf16*)(F.ws + WS_LW);
    constexpr int J1 = 32 * 58, J2 = 32 * 32, J3 = 32 * 16, I4 = 2 * 32, I5 = 4 * 32, I6 = 128;
    constexpr int NIT = J1 + J2 + J3 + 4 * I4 + I5 + I6;
    for (int it = F.gw; it < NIT; it += F.ngw) {
        int r = it;
        if (r < J1) { tr_job64(r, A.in[8], NIN, 0, 3712, W1T, 2048, 0, scr, F.lane); continue; } r -= J1;
        if (r < J2) { tr_job64(r, A.in[8], NIN, 3712, 2048, W1T, 2048, 3840, scr, F.lane); continue; } r -= J2;
        if (r < J3) { tr_job64(r, A.in[8], NIN, 5760, 1024, WVT, 2048, 0, scr, F.lane); continue; } r -= J3;
        if (r < I4) { tr_job(r, A.in[11], 1024, 0, 1024, 96, LW, 256, 0, scr, F.lane); continue; } r -= I4;
        if (r < I4) { tr_job(r, A.in[11] + 96 * 1024, 1024, 0, 1024, 96, LW + 1024 * 256, 256, 0, scr, F.lane); continue; } r -= I4;
        if (r < I4) { tr_job(r, A.in[13], 1024, 0, 1024, 96, LW + 2 * 1024 * 256, 256, 0, scr, F.lane); continue; } r -= I4;
        if (r < I4) { tr_job(r, A.in[13] + 96 * 1024, 1024, 0, 1024, 96, LW + 3 * 1024 * 256, 256, 0, scr, F.lane); continue; } r -= I4;
        if (r < I5) { tr_job(r, A.in[14], 1024, 0, 1024, 256, LW + 4 * 1024 * 256, 256, 0, scr, F.lane); continue; } r -= I5;
        { GAS v4u* z = (GAS v4u*)(W1T + (size_t)(3712 + r) * 2048) + F.lane; const v4u zz = {0u, 0u, 0u, 0u};
#pragma unroll
          for (int j = 0; j < 4; ++j) z[64 * j] = zz; }
    }
}

template <bool EXT>
__device__ __forceinline__ void phase_hx(const Frame& F, const Args& A, bf16* dst) {
    const float* sm = (const float*)(F.ws + WS_SMALL);
    const int nrows = EXT ? ME : ML;
    auto rowsrc = [&](int e) -> const GAS f32x4* {
        const float* src;
        if (EXT) { const int b = e / TE, j = e - b * TE; src = (j < CTXL) ? A.in[2] + (size_t)(b * CTXL + j) * D : A.in[0] + (size_t)(b * T + j - CTXL) * D; }
        else src = A.in[0] + (size_t)e * D;
        return (const GAS f32x4*)src + F.lane; };
    int e = F.gw;
    f32x4 v[8];
    if (e < nrows) { const GAS f32x4* xr = rowsrc(e);
#pragma unroll
        for (int q = 0; q < 8; ++q) v[q] = xr[64 * q]; }
    for (; e < nrows; e += F.ngw) {
        const int en = e + F.ngw;
        f32x4 vn[8];
        { const GAS f32x4* xr = rowsrc(en < nrows ? en : e);
#pragma unroll
          for (int q = 0; q < 8; ++q) vn[q] = xr[64 * q]; }
        const float* mod;
        if (EXT) { const int b = e / TE, j = e - b * TE; mod = sm + SM_MOD + ((j < CTXL) ? 4 : b) * 12288; }
        else mod = sm + SM_MOD + (e / T) * 12288;
        float s = 0.f;
#pragma unroll
        for (int q = 0; q < 8; ++q) s += (v[q].x * v[q].x + v[q].y * v[q].y) + (v[q].z * v[q].z + v[q].w * v[q].w);
        const float rstd = rsqrtf(wave_sum(s) * (1.0f / D) + 1e-6f);
        GAS v2u* o8 = (GAS v2u*)(dst + (size_t)e * D) + F.lane;
#pragma unroll
        for (int q = 0; q < 8; ++q) { const int c = 4 * F.lane + 256 * q;
            const f32x4 g = *(const f32x4*)(A.in[6] + c), sh = *(const f32x4*)(mod + c), sc = *(const f32x4*)(mod + 2048 + c);
            const f32x4 y = v[q] * rstd * g * (sc + 1.0f) + sh;
            v2u w; w.x = cvt_pk_bf16(y.x, y.y); w.y = cvt_pk_bf16(y.z, y.w); o8[64 * q] = w; }
#pragma unroll
        for (int q = 0; q < 8; ++q) v[q] = vn[q];
    }
}

struct SchedInproj {
    const char* hx; const char* w1t; const char* wvt; int G, c;
    static constexpr int N0 = 132 * 23, N1 = 4 * 132;
    __device__ __forceinline__ bool next(int i, Unit& u) const { const int L = i * G + c; if (L >= N0 + N1) return false;
        if (L < N0) { u.kind = 0; pg8::tile_order(L, 132, 23, u.pm, u.pn); } else { u.kind = 1; const int r = L - N0; u.pm = r & 3; u.pn = r >> 2; } return true; }
    __device__ __forceinline__ const char* a_ptr(const Unit& u) const { return (u.kind == 0 ? hx : wvt) + (size_t)u.pm * 256 * 2048 * 2; }
    __device__ __forceinline__ const char* b_ptr(const Unit& u) const { return (u.kind == 0 ? w1t : hx) + (size_t)u.pn * 256 * 2048 * 2; }
    __device__ __forceinline__ int nt(const Unit&) const { return 32; }
    __device__ __forceinline__ bool keep(const Unit&) const { return false; }
};
struct EpiInproj {
    bf16* P1; bf16* Vt;
    __device__ __forceinline__ void operator()(const f32x4 (&acc)[2][2][4][2], const Unit& u, int wr, int wc, int fr, int fq) const {
        bf16* base; size_t ldc;
        if (u.kind == 0) { base = P1 + (size_t)(u.pm * 256) * P1LD + u.pn * 256; ldc = P1LD; }
        else { const int b = u.pn / 33, jt = u.pn - b * 33; base = Vt + ((size_t)b * 1024 + u.pm * 256) * TE + jt * 256; ldc = TE; }
        const int row0 = wr * 64 + fr, col0 = wc * 32 + 8 * fq;
#pragma unroll
        for (int ai = 0; ai < 2; ++ai)
#pragma unroll
            for (int m = 0; m < 4; ++m) { bf16* rowp = base + (size_t)(row0 + ai * 128 + m * 16) * ldc + col0;
#pragma unroll
                for (int bj = 0; bj < 2; ++bj) { const f32x4 v0 = acc[ai][bj][m][0], v1 = acc[ai][bj][m][1];
                    v4u w; w.x = cvt_pk_bf16(v0[0], v0[1]); w.y = cvt_pk_bf16(v0[2], v0[3]); w.z = cvt_pk_bf16(v1[0], v1[1]); w.w = cvt_pk_bf16(v1[2], v1[3]);
                    *(v4u*)(rowp + bj * 128) = w; } }
    }
};

__device__ __forceinline__ void phase_e1(const Frame& F, const Args& A, const int pr = 0) {
    const float* sm = (const float*)(F.ws + WS_SMALL);
    bf16* P1 = (bf16*)(F.ws + WS_P1); bf16* XL = (bf16*)(F.ws + (pr ? 800 * MiB : WS_XL));
    bf16* QKD = pr ? (bf16*)(F.ws + 646 * MiB) : P1 + PQ; const int qkld = pr ? 2048 : P1LD;
    const int lane = F.lane, gidx = lane >> 1, half = lane & 1;
    const bool isq = gidx < 16;
    const int qkcol = (isq ? PQ + gidx * 64 : PK + (gidx - 16) * 64) + 32 * half;
    float gain[32];
#pragma unroll
    for (int i = 0; i < 32; ++i) gain[i] = (isq ? A.in[20] : A.in[21])[32 * half + i];
    for (int e = F.gw; e < ME; e += F.ngw) {
        const int b = e / TE, j = e - b * TE; const bool lat = j >= CTXL; const int t = j - CTXL;
        bf16* row = P1 + (size_t)e * P1LD;
        if (lat || !isq) {
            v4u raw[4];
#pragma unroll
            for (int q = 0; q < 4; ++q) raw[q] = *(const GAS v4u*)(row + qkcol + 8 * q);
            float v[32]; float ss = 0.f;
#pragma unroll
            for (int q = 0; q < 4; ++q)
#pragma unroll
                for (int w = 0; w < 4; ++w) { const unsigned x = raw[q][w]; v[8 * q + 2 * w] = bf2f(x & 0xffffu); v[8 * q + 2 * w + 1] = bf2f(x >> 16); }
#pragma unroll
            for (int i = 0; i < 32; ++i) ss += v[i] * v[i];
            ss += __shfl_xor(ss, 1);
            const float rstd = rsqrtf(ss * (1.0f / 64.0f) + 1e-6f);
#pragma unroll
            for (int i = 0; i < 32; ++i) v[i] = v[i] * rstd * gain[i];
            if (lat) {
                const int pos = half == 0 ? (t >> 6) : (t & 63);
                const f32x2* cs = (const f32x2*)(sm + SM_ROPE) + pos * 16;
#pragma unroll
                for (int i = 0; i < 16; ++i) { const f32x2 c = cs[i]; const float x1 = v[i], x2 = v[i + 16]; v[i] = x1 * c.x - x2 * c.y; v[i + 16] = x2 * c.x + x1 * c.y; }
            }
            if (isq) {
#pragma unroll
                for (int i = 0; i < 32; ++i) v[i] *= C2;
            }
#pragma unroll
            for (int q = 0; q < 4; ++q) { v4u w; w.x = cvt_pk_bf16(v[8 * q], v[8 * q + 1]); w.y = cvt_pk_bf16(v[8 * q + 2], v[8 * q + 3]); w.z = cvt_pk_bf16(v[8 * q + 4], v[8 * q + 5]); w.w = cvt_pk_bf16(v[8 * q + 6], v[8 * q + 7]);
                *(GAS v4u*)(QKD + (size_t)e * qkld + (qkcol - PQ) + 8 * q) = w; }
        }
        const bool hp = (j != 0) && (j != CTXL), hn = (j != CTXL - 1) && (j != TE - 1);
        bf16* xl = XL + (size_t)e * XLLD;
#pragma unroll
        for (int rnd = 0; rnd < 2; ++rnd) {
            const int og = lane + 64 * rnd;
            if (og < 96) {
                const int blk = og >> 4, gi = og & 15;
                v4u w = {0u, 0u, 0u, 0u};
                if (og >= 64 || gi < 12) {
                    const int c = og < 64 ? blk * 96 + gi * 8 : 384 + (og - 64) * 8, col = 3072 + c;
                    const v4u p0 = *(const GAS v4u*)(row + col);
                    v4u pp = {0u, 0u, 0u, 0u}, pn = {0u, 0u, 0u, 0u};
                    if (hp) pp = *(const GAS v4u*)(row + col - P1LD);
                    if (hn) pn = *(const GAS v4u*)(row + col + P1LD);
                    const f32x4 mu0 = *(const f32x4*)(A.in[9] + col), mu1 = *(const f32x4*)(A.in[9] + col + 4);
                    float o[8];
#pragma unroll
                    for (int q = 0; q < 4; ++q)
#pragma unroll
                        for (int hh = 0; hh < 2; ++hh) { const int sh = 16 * hh; const int idx = 2 * q + hh;
                            const float p = bf2f((p0[q] >> sh) & 0xffffu), a = bf2f((pp[q] >> sh) & 0xffffu), n = bf2f((pn[q] >> sh) & 0xffffu);
                            const float mu = idx < 4 ? mu0[idx & 3] : mu1[idx & 3];
                            const float sv = p + mu * (0.5f * (a + n) - p);
                            float r;
                            if (og >= 64) r = sigmoidf_(sv);
                            else if (blk < 2) { const float sc = fminf(fmaxf(sv, -15.f), 15.f); const float t2 = __expf(2.0f * sc); r = (t2 - 1.0f) * __builtin_amdgcn_rcpf(t2 + 1.0f); }
                            else r = sv;
                            o[idx] = r; }
                    w.x = cvt_pk_bf16(o[0], o[1]); w.y = cvt_pk_bf16(o[2], o[3]); w.z = cvt_pk_bf16(o[4], o[5]); w.w = cvt_pk_bf16(o[6], o[7]);
                }
                *(GAS v4u*)(xl + og * 8) = w;
            }
        }
    }
}

struct SchedLora {
    const char* xl; const char* lw; int G, c;
    __device__ __forceinline__ bool next(int i, Unit& u) const { const int L = i * G + c; if (L >= 5 * 528) return false; u.kind = L / 528; const int r = L - u.kind * 528; u.pm = r >> 2; u.pn = r & 3; return true; }
    __device__ __forceinline__ const char* a_ptr(const Unit& u) const { return xl + ((size_t)u.pm * 256 * XLLD + u.kind * 128) * 2; }
    __device__ __forceinline__ const char* b_ptr(const Unit& u) const { return lw + ((size_t)u.kind * 1024 + u.pn * 256) * 256 * 2; }
    __device__ __forceinline__ int nt(const Unit& u) const { return u.kind == 4 ? 4 : 2; }
    __device__ __forceinline__ bool keep(const Unit&) const { return false; }
};
struct EpiLora {
    unsigned short* LO; bf16* G; const float* w0; const float* a0;
    __device__ __forceinline__ void operator()(const f32x4 (&acc)[2][2][4][2], const Unit& u, int wr, int wc, int fr, int fq) const {
        const int row0 = u.pm * 256 + wr * 64 + fr, col0 = u.pn * 256 + wc * 32 + 8 * fq;
        const int kind = u.kind;
        unsigned short* base = (kind < 4) ? LO + (size_t)kind * ME * 1024 : G;
        const float* bias = (kind < 2) ? w0 + kind * 1024 : a0 + (kind & 1) * 1024;
#pragma unroll
        for (int bj = 0; bj < 2; ++bj) {
            f32x4 b0 = {0.f, 0.f, 0.f, 0.f}, b1 = {0.f, 0.f, 0.f, 0.f};
            if (kind < 4) { b0 = *(const f32x4*)(bias + col0 + bj * 128); b1 = *(const f32x4*)(bias + col0 + bj * 128 + 4); }
#pragma unroll
            for (int ai = 0; ai < 2; ++ai)
#pragma unroll
                for (int m = 0; m < 4; ++m) { f32x4 v0 = acc[ai][bj][m][0] + b0, v1 = acc[ai][bj][m][1] + b1; v4u w;
                    if (kind == 2 || kind == 3) {
                        v2u w8; unsigned q8[8];
#pragma unroll
                        for (int q = 0; q < 4; ++q) { q8[q] = (unsigned)(sigmoidf_(v0[q]) * 255.0f + 0.5f); q8[4 + q] = (unsigned)(sigmoidf_(v1[q]) * 255.0f + 0.5f); }
                        w8.x = q8[0] | (q8[1] << 8) | (q8[2] << 16) | (q8[3] << 24); w8.y = q8[4] | (q8[5] << 8) | (q8[6] << 16) | (q8[7] << 24);
                        *(v2u*)((unsigned char*)(LO + (size_t)2 * ME * 1024) + ((size_t)(kind - 2) * ME + (row0 + ai * 128 + m * 16)) * 1024 + col0 + bj * 128) = w8;
                        continue; }
                    if (kind < 4) { const float sc = 0.6065306597126334f;
#pragma unroll
                        for (int q = 0; q < 4; ++q) { v0[q] = sc * sigmoidf_(v0[q]); v1[q] = sc * sigmoidf_(v1[q]); }
                        w.x = pk_f16(v0[0], v0[1]); w.y = pk_f16(v0[2], v0[3]); w.z = pk_f16(v1[0], v1[1]); w.w = pk_f16(v1[2], v1[3]); }
                    else { w.x = cvt_pk_bf16(v0[0], v0[1]); w.y = cvt_pk_bf16(v0[2], v0[3]); w.z = cvt_pk_bf16(v1[0], v1[1]); w.w = cvt_pk_bf16(v1[2], v1[3]); }
                    *(v4u*)(base + (size_t)(row0 + ai * 128 + m * 16) * 1024 + col0 + bj * 128) = w; }
        }
    }
};

__device__ __forceinline__ int sc_tok(int dir, int sidx) { return dir == 0 ? sidx : (sidx < CTXL ? CTXL - 1 - sidx : TE + CTXL - 1 - sidx); }
constexpr int S2_NCH = TE / 32, S2_NS = 5, S2_SLOT = 24576, S2_ZY = 12288, S2_PAR = S2_NS * S2_SLOT;
typedef f32x16 C16;
struct Fr2 { bf16x8 k[2]; };
#define S2_DPP(v, ctrl, rm) __builtin_bit_cast(float, __builtin_amdgcn_update_dpp(0, __builtin_bit_cast(int, (v)), (ctrl), (rm), 0xF, false))
__device__ __forceinline__ float s2_prefix32(float v) {
    v += S2_DPP(v, 0x111, 0xF); v += S2_DPP(v, 0x112, 0xF); v += S2_DPP(v, 0x114, 0xF); v += S2_DPP(v, 0x118, 0xF); v += S2_DPP(v, 0x142, 0xA);
    return v;
}
__device__ __forceinline__ bf16x8 s2_pk8(const float* x) { v4u a; a.x = cvt_pk_bf16(x[0], x[1]); a.y = cvt_pk_bf16(x[2], x[3]); a.z = cvt_pk_bf16(x[4], x[5]); a.w = cvt_pk_bf16(x[6], x[7]); return __builtin_bit_cast(bf16x8, a); }
__device__ __forceinline__ Fr2 s2_pack(const C16& x, const float sg = 1.0f) {
    Fr2 f; v4u a, b;
    a.x = cvt_pk_bf16(sg * x[0], sg * x[1]); a.y = cvt_pk_bf16(sg * x[2], sg * x[3]); a.z = cvt_pk_bf16(sg * x[4], sg * x[5]); a.w = cvt_pk_bf16(sg * x[6], sg * x[7]);
    b.x = cvt_pk_bf16(sg * x[8], sg * x[9]); b.y = cvt_pk_bf16(sg * x[10], sg * x[11]); b.z = cvt_pk_bf16(sg * x[12], sg * x[13]); b.w = cvt_pk_bf16(sg * x[14], sg * x[15]);
    f.k[0] = __builtin_bit_cast(bf16x8, a); f.k[1] = __builtin_bit_cast(bf16x8, b); return f;
}
#define S2_MF(A_, B_, C_) __builtin_amdgcn_mfma_f32_32x32x16_bf16((A_), (B_), (C_), 0, 0, 0)
__device__ __forceinline__ C16 s2_mm2(const Fr2& A, const Fr2& B, C16 acc) { acc = S2_MF(A.k[0], B.k[0], acc); acc = S2_MF(A.k[1], B.k[1], acc); return acc; }
__device__ __forceinline__ C16 s2_mm4(const bf16x8* A, const bf16x8* B) {
    C16 acc;
#pragma unroll
    for (int r = 0; r < 16; ++r) acc[r] = 0.f;
#pragma unroll
    for (int s = 0; s < 4; ++s) acc = S2_MF(A[s], B[s], acc);
    return acc;
}
__device__ __forceinline__ C16 s2_zero() { C16 z;
#pragma unroll
    for (int r = 0; r < 16; ++r) z[r] = 0.f;
    return z; }
#define S2_ROW(r, hi) (8 * ((r) >> 2) + 4 * (hi) + ((r) & 3))
__device__ __forceinline__ unsigned s2_poll(volatile LAS unsigned* p) { return *p; }

__device__ __forceinline__ void phase_scan(const Frame& F, const Args& A) {
    const bf16* P1 = (const bf16*)(F.ws + WS_P1);
    const unsigned short* LO = (const unsigned short*)(F.ws + WS_LO);
    LAS unsigned char* lds = F.lds;
    const int lane = F.lane, wave = F.wave, n32 = lane & 31, hi = lane >> 5;
    volatile LAS unsigned* flg = (volatile LAS unsigned*)(lds + LDSCTL_OFF);
    LAS float* par = (LAS float*)(lds + S2_PAR);
    for (int item = F.bid; item < 128; item += F.G) {
        const int dir = item & 1, h = (item >> 1) & 15, b = item >> 5;
        bf16* Yd = dir ? (bf16*)(F.ws + WS_YB) : (bf16*)((unsigned char*)A.out + OUT_YF);
        __syncthreads();
        if (F.tid < 32) flg[F.tid] = 0u;
        if (F.tid < 384) { const int q = F.tid >> 6, cc = h * 64 + (F.tid & 63);
            par[F.tid] = q == 0 ? A.in[9][cc] : (q == 1 ? A.in[9][1024 + cc] : (q == 2 ? A.in[9][2048 + cc] : (q == 3 ? A.in[15][cc] : (q == 4 ? A.in[16][cc] : A.in[17][cc])))); }
        __syncthreads();
        if (wave == 0) {
            C16 St[2][2];
#pragma unroll
            for (int a = 0; a < 2; ++a) { St[a][0] = s2_zero(); St[a][1] = s2_zero(); }
            Fr2 IdT;
#pragma unroll
            for (int s1 = 0; s1 < 2; ++s1) { float t8[8];
#pragma unroll
                for (int i = 0; i < 8; ++i) t8[i] = (S2_ROW(8 * s1 + i, hi) == n32) ? 1.0f : 0.0f;
                IdT.k[s1] = s2_pk8(t8); }
            for (int c = 0; c < S2_NCH; ++c) {
                const int slot = c % S2_NS; const LAS unsigned char* sb = lds + slot * S2_SLOT;
                { unsigned sp = 0; while (s2_poll(flg + slot) < (unsigned)(c + 1)) { __builtin_amdgcn_s_sleep(1); if (++sp > (1u << 24)) break; } }
                asm volatile("" ::: "memory");
                Fr2 bS[2][2];
#pragma unroll
                for (int a = 0; a < 2; ++a) { bS[a][0] = s2_pack(St[a][0]); bS[a][1] = s2_pack(St[a][1]); }
                C16 acc[2][3];
#pragma unroll
                for (int a = 0; a < 2; ++a)
#pragma unroll
                    for (int mz = 0; mz < 3; ++mz) {
                        const v4u q0 = *(const LAS v4u*)(sb + S2_ZY + (((mz * 2 + a) * 2 + 0) * 64 + lane) * 16), q1 = *(const LAS v4u*)(sb + S2_ZY + (((mz * 2 + a) * 2 + 1) * 64 + lane) * 16);
#pragma unroll
                        for (int d = 0; d < 4; ++d) { acc[a][mz][2 * d] = bf2f(q0[d] & 0xffffu); acc[a][mz][2 * d + 1] = bf2f(q0[d] >> 16); acc[a][mz][8 + 2 * d] = bf2f(q1[d] & 0xffffu); acc[a][mz][8 + 2 * d + 1] = bf2f(q1[d] >> 16); }
                    }
#pragma unroll
                for (int nb = 0; nb < 3; ++nb)
#pragma unroll
                    for (int s = 0; s < 4; ++s) { const bf16x8 af = *(const LAS bf16x8*)(sb + ((nb * 4 + s) * 64 + lane) * 16);
                        acc[0][nb] = S2_MF(af, bS[0][s >> 1].k[s & 1], acc[0][nb]); acc[1][nb] = S2_MF(af, bS[1][s >> 1].k[s & 1], acc[1][nb]); }
                asm volatile("s_waitcnt lgkmcnt(0)" ::: "memory");
                if (lane == 0) flg[8 + slot] = (unsigned)(c + 1);
#pragma unroll
                for (int a = 0; a < 2; ++a) { St[a][0] = acc[a][1]; St[a][1] = acc[a][2]; }
                if (c >= CTXL / 32) {
                    const int sidx = 32 * c + n32; const int j = dir == 0 ? sidx : (TE + CTXL - 1 - sidx);
                    bf16* yp = Yd + ((size_t)b * T + (j - CTXL)) * 1024 + h * 64 + 4 * hi;
#pragma unroll
                    for (int a = 0; a < 2; ++a) { const Fr2 yf = s2_pack(acc[a][0]); const C16 yt = s2_mm2(yf, IdT, s2_zero());
#pragma unroll
                        for (int g4 = 0; g4 < 4; ++g4) { v2u w; w.x = cvt_pk_bf16(yt[4 * g4], yt[4 * g4 + 1]); w.y = cvt_pk_bf16(yt[4 * g4 + 2], yt[4 * g4 + 3]); *(GAS v2u*)(yp + 32 * a + 8 * g4) = w; } }
                }
            }
        } else {
            const unsigned short* LOw = LO + (size_t)dir * ME * 1024; const unsigned char* LOa = (const unsigned char*)(LO + (size_t)2 * ME * 1024) + (size_t)dir * ME * 1024;
            bf16x8 IdF[2];
#pragma unroll
            for (int s1 = 0; s1 < 2; ++s1) { float t8[8];
#pragma unroll
                for (int i = 0; i < 8; ++i) t8[i] = (16 * s1 + 8 * hi + i == n32) ? 1.0f : 0.0f;
                IdF[s1] = s2_pk8(t8); }
            const bool have = (hi == ((n32 >> 3) & 1));
            for (;;) {
                unsigned cv; { const unsigned ca = (unsigned)(size_t)(lds + LDSCTL_OFF + 96), one = lane == 0 ? 1u : 0u;
                    asm volatile("ds_add_rtn_u32 %0, %1, %2\n\ts_waitcnt lgkmcnt(0)" : "=v"(cv) : "v"(ca), "v"(one) : "memory"); }
                const int c = __builtin_amdgcn_readfirstlane((int)cv);
                if (c >= S2_NCH) break;
                int nq = n32, hq = hi;
#define S2_OPQ() asm volatile("" : "+v"(nq), "+v"(hq))
                S2_OPQ();
                const int j = sc_tok(dir, 32 * c + n32);
                const size_t e = (size_t)b * TE + j;
                const bool hp = (j != 0) && (j != CTXL), hn = (j != CTXL - 1) && (j != TE - 1);
                const bf16* row = P1 + e * P1LD + h * 64 + 8 * hi; const bf16* rowp = hp ? row - P1LD : row; const bf16* rown = hn ? row + P1LD : row;
                const float fp = hp ? 0.5f : 0.f, fn = hn ? 0.5f : 0.f;
                const unsigned short* lw = LOw + e * 1024 + h * 64 + 8 * hi; const unsigned char* la = LOa + e * 1024 + h * 64 + 8 * hi;
                const LAS float* pl = par + 8 * hi;
                v4u RtF[4], KtF[4], CtF[4], BtF[4]; float ptsel[2] = {0.f, 0.f}, ssq = 0.f;
#pragma unroll
                for (int s = 0; s < 4; ++s) {
                    const v4u r0 = *(const GAS v4u*)(row + 16 * s), rp = *(const GAS v4u*)(rowp + 16 * s), rx = *(const GAS v4u*)(rown + 16 * s);
                    const v4u k0 = *(const GAS v4u*)(row + 1024 + 16 * s), kp = *(const GAS v4u*)(rowp + 1024 + 16 * s), kn = *(const GAS v4u*)(rown + 1024 + 16 * s);
                    const v4u ewr = *(const GAS v4u*)(lw + 16 * s); const v2u awr = *(const GAS v2u*)(la + 16 * s);
#pragma unroll
                    for (int w = 0; w < 4; ++w) { float oR[2], oK[2], oC[2], oB[2];
                        const LAS float* plw = pl + 16 * s + 2 * w; asm volatile("" : "+v"(plw));
#pragma unroll
                        for (int q = 0; q < 2; ++q) { const int i = 2 * w + q, sh = 16 * q;
                            const float r_0 = bf2f((r0[w] >> sh) & 0xffffu), r_p = bf2f((rp[w] >> sh) & 0xffffu), r_n = bf2f((rx[w] >> sh) & 0xffffu);
                            const float k_0 = bf2f((k0[w] >> sh) & 0xffffu), k_p = bf2f((kp[w] >> sh) & 0xffffu), k_n = bf2f((kn[w] >> sh) & 0xffffu);
                            const float mr = plw[q], mk = plw[64 + q], kkw = plw[192 + q], kaw = plw[256 + q];
                            const float rs = r_0 + mr * ((fp * r_p + fn * r_n) - r_0), ksv = k_0 + mk * ((fp * k_p + fn * k_n) - k_0);
                            const float av = (float)((awr[w >> 1] >> (8 * (2 * (w & 1) + q))) & 0xffu) * (1.0f / 255.0f);
                            const float e2 = (q ? f16hi(ewr[w]) : f16lo(ewr[w])) * 1.4426950408889634f;
                            const float Pp2 = s2_prefix32(e2);
                            const float Pt = __shfl(Pp2, lane | 31);
                            if (16 * (s & 1) + 8 * hq + i == nq) ptsel[s >> 1] = Pt;
                            const float g = __builtin_amdgcn_exp2f(-Pp2), gi = __builtin_amdgcn_exp2f(Pp2), gp = __builtin_amdgcn_exp2f(e2 - Pp2);
                            const float kkn = ksv * kkw, be = av * kkn, kd = ksv * ((av - 1.0f) * kaw + 1.0f); ssq += kkn * kkn;
                            oR[q] = rs * g; oK[q] = kd * gi; oC[q] = kkn * gp; oB[q] = be * gi; }
                        RtF[s][w] = cvt_pk_bf16(oR[0], oR[1]); KtF[s][w] = cvt_pk_bf16(oK[0], oK[1]); CtF[s][w] = cvt_pk_bf16(oC[0], oC[1]); BtF[s][w] = cvt_pk_bf16(oB[0], oB[1]);
                        __builtin_amdgcn_sched_barrier(0); }
                }
#define S2_F(X, s) __builtin_bit_cast(bf16x8, X[s])
                { ssq += __shfl_xor(ssq, 32); const float rn = rsqrtf(ssq + 1e-12f);
#pragma unroll
                  for (int s = 0; s < 4; ++s)
#pragma unroll
                      for (int w = 0; w < 4; ++w) { const unsigned x = CtF[s][w], y = BtF[s][w];
                          CtF[s][w] = cvt_pk_bf16(bf2f(x & 0xffffu) * rn, __uint_as_float(x & 0xffff0000u) * rn); BtF[s][w] = cvt_pk_bf16(bf2f(y & 0xffffu) * rn, __uint_as_float(y & 0xffff0000u) * rn); } }
                float gcf[2], gd[2];
#pragma unroll
                for (int nb = 0; nb < 2; ++nb) { const float o = __shfl_xor(ptsel[nb], 32); gcf[nb] = __builtin_amdgcn_exp2f(-(have ? ptsel[nb] : o)); gd[nb] = have ? gcf[nb] : 0.f; }
                Fr2 Pp, PTp, nM1T, N2p; C16 TT, N1;
                { C16 t = s2_zero();
#pragma unroll
                  for (int s = 0; s < 4; ++s) t = S2_MF(S2_F(BtF, s), S2_F(CtF, s), t);
#pragma unroll
                  for (int r = 0; r < 16; ++r) t[r] = (S2_ROW(r, hq) < nq) ? -t[r] : 0.f;
                  Pp = s2_pack(t); }
                __builtin_amdgcn_sched_barrier(0); S2_OPQ();
                { C16 t = s2_zero();
#pragma unroll
                  for (int s = 0; s < 4; ++s) t = S2_MF(S2_F(CtF, s), S2_F(BtF, s), t);
#pragma unroll
                  for (int r = 0; r < 16; ++r) t[r] = (nq < S2_ROW(r, hq)) ? -t[r] : 0.f;
                  PTp = s2_pack(t);
#pragma unroll
                  for (int r = 0; r < 16; ++r) t[r] += (S2_ROW(r, hq) == nq) ? 1.0f : 0.f;
                  TT = t; }
                __builtin_amdgcn_sched_barrier(0); S2_OPQ();
                { C16 t = s2_zero();
#pragma unroll
                  for (int s = 0; s < 4; ++s) t = S2_MF(S2_F(CtF, s), S2_F(KtF, s), t);
#pragma unroll
                  for (int r = 0; r < 16; ++r) t[r] = (nq < S2_ROW(r, hq)) ? -t[r] : 0.f;
                  nM1T = s2_pack(t); }
                __builtin_amdgcn_sched_barrier(0); S2_OPQ();
                { C16 t = s2_zero();
#pragma unroll
                  for (int s = 0; s < 4; ++s) t = S2_MF(S2_F(BtF, s), S2_F(RtF, s), t);
#pragma unroll
                  for (int r = 0; r < 16; ++r) t[r] = (S2_ROW(r, hq) <= nq) ? t[r] : 0.f;
                  N2p = s2_pack(t); }
                __builtin_amdgcn_sched_barrier(0); S2_OPQ();
                { C16 t = s2_zero();
#pragma unroll
                  for (int s = 0; s < 4; ++s) t = S2_MF(S2_F(KtF, s), S2_F(RtF, s), t);
#pragma unroll
                  for (int r = 0; r < 16; ++r) t[r] = (S2_ROW(r, hq) <= nq) ? t[r] : 0.f;
                  N1 = t; }
                __builtin_amdgcn_sched_barrier(0); S2_OPQ();
#pragma unroll
                for (int lv = 0; lv < 4; ++lv) {
                    const Fr2 P2p = s2_pack(s2_mm2(PTp, Pp, s2_zero()));
                    if (lv < 3) PTp = s2_pack(s2_mm2(Pp, PTp, s2_zero()));
                    TT = s2_mm2(P2p, s2_pack(TT), TT);
                    Pp = P2p;
                    __builtin_amdgcn_sched_barrier(0);
                }
                const Fr2 TTp = s2_pack(TT);
                Fr2 Xp[3];
                Xp[0] = s2_pack(s2_mm2(TTp, N2p, s2_zero()));
#pragma unroll
                for (int nb = 0; nb < 2; ++nb) { C16 BtL = S2_MF(S2_F(BtF, 2 * nb), IdF[0], s2_zero()); BtL = S2_MF(S2_F(BtF, 2 * nb + 1), IdF[1], BtL);
                    Xp[1 + nb] = s2_pack(s2_mm2(TTp, s2_pack(BtL), s2_zero()), gcf[nb]); }
                __builtin_amdgcn_sched_barrier(0);
                const int slot = c % S2_NS; LAS unsigned char* sb = lds + slot * S2_SLOT;
                if (c >= S2_NS) { unsigned sp = 0; const unsigned need = (unsigned)(c - S2_NS + 1);
                    while (s2_poll(flg + 8 + slot) < need) { __builtin_amdgcn_s_sleep(1); if (++sp > (1u << 24)) break; } }
                asm volatile("" ::: "memory");
#pragma unroll
                for (int mb = 0; mb < 2; ++mb) {
                    C16 CtL = S2_MF(S2_F(CtF, 2 * mb), IdF[0], s2_zero()); CtL = S2_MF(S2_F(CtF, 2 * mb + 1), IdF[1], CtL);
                    const Fr2 nCt = s2_pack(CtL, -1.0f);
#pragma unroll
                    for (int nb = 0; nb < 3; ++nb) {
                        C16 acc = s2_zero();
                        if (nb == 0) { acc = S2_MF(IdF[0], S2_F(RtF, 2 * mb), acc); acc = S2_MF(IdF[1], S2_F(RtF, 2 * mb + 1), acc); }
                        else if (nb == 1 + mb) {
#pragma unroll
                            for (int s1 = 0; s1 < 2; ++s1) { float t8[8];
#pragma unroll
                                for (int i = 0; i < 8; ++i) t8[i] = (16 * s1 + 8 * hq + i == nq) ? gd[mb] : 0.0f;
                                acc = S2_MF(IdF[s1], s2_pk8(t8), acc); } }
                        acc = s2_mm2(nCt, Xp[nb], acc);
                        const Fr2 o = s2_pack(acc);
                        *(LAS bf16x8*)(sb + ((nb * 4 + 2 * mb + 0) * 64 + lane) * 16) = o.k[0]; *(LAS bf16x8*)(sb + ((nb * 4 + 2 * mb + 1) * 64 + lane) * 16) = o.k[1];
                        __builtin_amdgcn_sched_barrier(0);
                    }
                }
                Fr2 VsL[2];
#pragma unroll
                for (int nb = 0; nb < 2; ++nb) { C16 t = s2_zero();
#pragma unroll
                    for (int s1 = 0; s1 < 2; ++s1) { const int s = 2 * nb + s1;
                        const v4u v0 = *(const GAS v4u*)(row + 2048 + 16 * s), vp = *(const GAS v4u*)(rowp + 2048 + 16 * s), vx = *(const GAS v4u*)(rown + 2048 + 16 * s);
                        const LAS float* plw = pl + 128 + 16 * s; asm volatile("" : "+v"(plw));
                        v4u vf;
#pragma unroll
                        for (int w = 0; w < 4; ++w) { float ov[2];
#pragma unroll
                            for (int q = 0; q < 2; ++q) { const int sh = 16 * q; const float v_0 = bf2f((v0[w] >> sh) & 0xffffu), v_p = bf2f((vp[w] >> sh) & 0xffffu), v_n = bf2f((vx[w] >> sh) & 0xffffu);
                                ov[q] = v_0 + plw[2 * w + q] * ((fp * v_p + fn * v_n) - v_0); }
                            vf[w] = cvt_pk_bf16(ov[0], ov[1]); }
                        t = S2_MF(__builtin_bit_cast(bf16x8, vf), IdF[s1], t); }
                    VsL[nb] = s2_pack(t); }
#pragma unroll
                for (int mz = 0; mz < 3; ++mz) {
                    C16 Wb;
                    if (mz == 0) Wb = N1; else { Wb = S2_MF(S2_F(KtF, 2 * (mz - 1)), IdF[0], s2_zero()); Wb = S2_MF(S2_F(KtF, 2 * (mz - 1) + 1), IdF[1], Wb);
#pragma unroll
                        for (int r = 0; r < 16; ++r) Wb[r] *= gcf[mz - 1]; }
                    const Fr2 Wp = s2_pack(s2_mm2(nM1T, Xp[mz], Wb));
#pragma unroll
                    for (int nr = 0; nr < 2; ++nr) { const Fr2 o = s2_pack(s2_mm2(Wp, VsL[nr], s2_zero()));
                        *(LAS bf16x8*)(sb + S2_ZY + (((mz * 2 + nr) * 2 + 0) * 64 + lane) * 16) = o.k[0]; *(LAS bf16x8*)(sb + S2_ZY + (((mz * 2 + nr) * 2 + 1) * 64 + lane) * 16) = o.k[1]; }
                    __builtin_amdgcn_sched_barrier(0);
                }
                {
                    float bon = 0.f;
#pragma unroll
                    for (int s = 0; s < 4; ++s) { const LAS float* plw = pl + 320 + 16 * s; asm volatile("" : "+v"(plw));
#pragma unroll
                        for (int w = 0; w < 4; ++w) { const unsigned x = RtF[s][w], y = KtF[s][w];
                            bon += bf2f(x & 0xffffu) * bf2f(y & 0xffffu) * plw[2 * w] + __uint_as_float(x & 0xffff0000u) * __uint_as_float(y & 0xffff0000u) * plw[2 * w + 1]; } }
                    bon += __shfl_xor(bon, 32);
                    const int jb = sc_tok(dir, 32 * c + nq);
                    if (hq == 0 && jb >= CTXL) ((float*)(F.ws + WS_BON))[((size_t)dir * ML + (size_t)b * T + (jb - CTXL)) * 16 + h] = bon; }
                asm volatile("s_waitcnt lgkmcnt(0)" ::: "memory");
                if (lane == 0) flg[slot] = (unsigned)(c + 1);
            }
#undef S2_F
#undef S2_OPQ
        }
        asm volatile("s_waitcnt vmcnt(0) lgkmcnt(0)" ::: "memory");
        __syncthreads();
        if (F.tid == 0) { __builtin_amdgcn_fence(__ATOMIC_RELEASE, "agent"); asm volatile("s_waitcnt vmcnt(0)" ::: "memory");
            (void)__hip_atomic_fetch_add((unsigned*)(F.ws + WS_CTL) + CW_ATT + 704, 1u, RLX_AGENT); }
    }
}


__device__ __forceinline__ void phase_rcomb(const Frame& F, const Args& A, const int pr = 0, const int tail = 0) {
    const bf16* P1 = (const bf16*)(F.ws + WS_P1);
    const bf16* Gb = (const bf16*)(F.ws + WS_G);
    const float* BON = (const float*)(F.ws + WS_BON);
    bf16* YF = (bf16*)((unsigned char*)A.out + OUT_YF); const bf16* YB = (const bf16*)(F.ws + WS_YB);
    const int lane = F.lane, c0 = 16 * lane;
    struct RowIn { v4u x0[2], xp[2], xn[2], yf[2], yb[2], gg[2]; float cf; };
    auto rload = [&](const int m, RowIn& R) {
        const int b = m / T, t = m - b * T, j = t + CTXL; const size_t e = (size_t)b * TE + j;
        const bool hp = (j != CTXL), hn = (j != TE - 1);
        const bf16* p = P1 + e * P1LD + c0 + 2048;
        R.cf = BON[(size_t)m * 16 + (lane >> 2)] + BON[((size_t)ML + m) * 16 + (lane >> 2)];
#pragma unroll
        for (int hh = 0; hh < 2; ++hh) {
            R.x0[hh] = *(const GAS v4u*)(p + 8 * hh);
            R.xp[hh] = (v4u){0u, 0u, 0u, 0u}; R.xn[hh] = (v4u){0u, 0u, 0u, 0u};
            if (hp) R.xp[hh] = *(const GAS v4u*)(p - P1LD + 8 * hh);
            if (hn) R.xn[hh] = *(const GAS v4u*)(p + P1LD + 8 * hh);
            R.yf[hh] = *(const GAS v4u*)(YF + (size_t)m * 1024 + c0 + 8 * hh); R.yb[hh] = *(const GAS v4u*)(YB + (size_t)m * 1024 + c0 + 8 * hh); R.gg[hh] = *(const GAS v4u*)(Gb + e * 1024 + c0 + 8 * hh);
        }
    };
    auto rfin = [&](const int m, const RowIn& R) {
        const float cf = R.cf;
        float v[16];
#pragma unroll
        for (int hh = 0; hh < 2; ++hh) {
            const v4u x0 = R.x0[hh], xp = R.xp[hh], xn = R.xn[hh];
            const f32x4 mu0 = *(const f32x4*)(A.in[9] + 2048 + c0 + 8 * hh), mu1 = *(const f32x4*)(A.in[9] + 2048 + c0 + 8 * hh + 4);
#pragma unroll
            for (int w = 0; w < 4; ++w) {
                const float a0 = bf2f(x0[w] & 0xffffu), a1 = bf2f(x0[w] >> 16);
                const float p0 = bf2f(xp[w] & 0xffffu), p1 = bf2f(xp[w] >> 16), n0 = bf2f(xn[w] & 0xffffu), n1 = bf2f(xn[w] >> 16);
                const float m0 = (w < 2) ? mu0[2 * w] : mu1[2 * w - 4], m1 = (w < 2) ? mu0[2 * w + 1] : mu1[2 * w - 3];
                v[8 * hh + 2 * w] = a0 + m0 * (0.5f * (p0 + n0) - a0); v[8 * hh + 2 * w + 1] = a1 + m1 * (0.5f * (p1 + n1) - a1);
            }
        }
        float y[16], g[16];
#pragma unroll
        for (int hh = 0; hh < 2; ++hh) {
            const v4u yf = R.yf[hh], yb = R.yb[hh], gg = R.gg[hh];
#pragma unroll
            for (int w = 0; w < 4; ++w) { y[8 * hh + 2 * w] = bf2f(yf[w] & 0xffffu) + bf2f(yb[w] & 0xffffu); y[8 * hh + 2 * w + 1] = bf2f(yf[w] >> 16) + bf2f(yb[w] >> 16);
                g[8 * hh + 2 * w] = bf2f(gg[w] & 0xffffu); g[8 * hh + 2 * w + 1] = bf2f(gg[w] >> 16); }
        }
        float s = 0.f;
#pragma unroll
        for (int i = 0; i < 16; ++i) s += y[i];
        s += __shfl_xor(s, 1); s += __shfl_xor(s, 2);
        const float mean = s * (1.0f / 64.0f); float q2 = 0.f;
#pragma unroll
        for (int i = 0; i < 16; ++i) { const float d = y[i] - mean; q2 += d * d; }
        q2 += __shfl_xor(q2, 1); q2 += __shfl_xor(q2, 2);
        const float rstd = rsqrtf(q2 * (1.0f / 64.0f) + 64e-5f);
        float o[16];
#pragma unroll
        for (int i = 0; i < 16; ++i) { const float yn = (y[i] - mean) * rstd * A.in[18][c0 + i] + A.in[19][c0 + i]; o[i] = (yn + cf * v[i]) * g[i]; }
#pragma unroll
        for (int hh = 0; hh < 2; ++hh) { v4u w; w.x = cvt_pk_bf16(o[8 * hh], o[8 * hh + 1]); w.y = cvt_pk_bf16(o[8 * hh + 2], o[8 * hh + 3]); w.z = cvt_pk_bf16(o[8 * hh + 4], o[8 * hh + 5]); w.w = cvt_pk_bf16(o[8 * hh + 6], o[8 * hh + 7]);
            *(GAS v4u*)((pr ? (bf16*)(F.ws + WS_VT) : YF) + (size_t)m * 1024 + c0 + 8 * hh) = w; }
    };
    auto row = [&](const int m) { RowIn R; rload(m, R); rfin(m, R); };
    if (!tail) { for (int m = F.gw; m < ML; m += F.ngw) row(m); return; }
    unsigned* ctl = (unsigned*)(F.ws + WS_CTL) + CW_ATT;
    volatile LAS unsigned* unw = (volatile LAS unsigned*)(F.lds + LDSCTL_OFF + 256);
    __syncthreads();
    if (F.tid == 0) { unsigned sp = 0; while (__hip_atomic_load(ctl + 704, RLX_AGENT) < 128u) { __builtin_amdgcn_s_sleep(4); if (++sp > (1u << 22)) break; }
        __builtin_amdgcn_fence(__ATOMIC_ACQUIRE, "agent"); asm volatile("s_waitcnt vmcnt(0)" ::: "memory"); }
    __syncthreads();
    for (;;) {
        __syncthreads();
        if (F.tid == 0) unw[0] = __hip_atomic_fetch_add(ctl + 768, 64u, RLX_AGENT);
        __syncthreads();
        const int r0 = (int)unw[0];
        if (r0 >= ML) break;
        { const int m0 = r0 + F.wave * 8; RowIn ra, rb;
          rload(m0, ra);
#pragma unroll 1
          for (int k = 0; k < 8; k += 2) { rload(m0 + k + 1, rb); rfin(m0 + k, ra); if (k + 2 < 8) rload(m0 + k + 2, ra); rfin(m0 + k + 1, rb); } }
    }
}

constexpr int AT_K = 0, AT_V = 16384, AT_BUF = 32768;
__device__ __forceinline__ void phase_attn(const Frame& F, const Args& A) {
    const float* sm = (const float*)(F.ws + WS_SMALL);
    const bf16* P1 = (const bf16*)(F.ws + WS_P1); const bf16* Vt = (const bf16*)(F.ws + WS_VT); bf16* YD = (bf16*)(F.ws + WS_YD);
    const float lam = sm[SM_MISC + 0], smax2 = sm[SM_MISC + 1];
    const int tid = F.tid, lane = F.lane, wid = F.wave, r32 = lane & 31, hi = lane >> 5, map = wid & 1, qg = wid >> 1;
    const int pir = (r32 & 0x13) | ((r32 & 4) << 1) | ((r32 & 8) >> 1);
    LAS unsigned char* lds = F.lds;
    for (int un = F.bid; un < NB * 8 * 64; un += F.G) {
        const int qt = un & 63, h = (un >> 6) & 7, b = un >> 9;
        const bf16* Kg = P1 + (size_t)b * TE * P1LD + PK + h * 128;
        const bf16* Vg = Vt + ((size_t)b * 1024 + h * 128) * TE;
        const bf16* ksrc[2]; const bf16* vsrc[2]; int kdst[2], vdst[2];
#pragma unroll
        for (int i = 0; i < 2; ++i) { const int p = tid + 512 * i; const int key = p >> 4, c16 = p & 15; ksrc[i] = Kg + (size_t)key * P1LD + c16 * 8; kdst[i] = AT_K + (c16 >> 3) * 8192 + (c16 & 7) * 1024 + key * 16;
            const int dv = p >> 3, c = p & 7; vsrc[i] = Vg + (size_t)dv * TE + c * 8; vdst[i] = AT_V + dv * 128 + ((c ^ ((dv >> 1) & 7)) * 16); }
        const size_t erow = (size_t)b * TE + CTXL + qt * 128 + qg * 32 + r32;
        bf16x8 qr[4];
#pragma unroll
        for (int d0 = 0; d0 < 4; ++d0) qr[d0] = *(const GAS bf16x8*)(P1 + erow * P1LD + PQ + h * 128 + map * 64 + d0 * 16 + hi * 8);
        f32x16 o[4];
#pragma unroll
        for (int vb = 0; vb < 4; ++vb)
#pragma unroll
            for (int r = 0; r < 16; ++r) o[vb][r] = 0.f;
        float lsum = 0.f;
        f32x16 negm;
#pragma unroll
        for (int r = 0; r < 16; ++r) negm[r] = -smax2;
        v4u kreg[2], vreg[2];
#pragma unroll
        for (int i = 0; i < 2; ++i) { kreg[i] = *(const GAS v4u*)(ksrc[i]); vreg[i] = *(const GAS v4u*)(vsrc[i]); }
        __syncthreads();
#pragma unroll
        for (int i = 0; i < 2; ++i) { *(LAS v4u*)(lds + kdst[i]) = kreg[i]; *(LAS v4u*)(lds + vdst[i]) = vreg[i]; }
        __syncthreads();
        constexpr int NTILE = TE / 64;
        for (int tI = 0; tI < NTILE; ++tI) {
            const int cur = (tI & 1) * AT_BUF, nxb = ((tI + 1) & 1) * AT_BUF;
            if (tI + 1 < NTILE) {
#pragma unroll
                for (int i = 0; i < 2; ++i) { kreg[i] = *(const GAS v4u*)(ksrc[i] + (size_t)(tI + 1) * 64 * P1LD); vreg[i] = *(const GAS v4u*)(vsrc[i] + (tI + 1) * 64); }
            }
            const LAS unsigned char* kb = lds + cur + AT_K + map * 8192 + hi * 1024 + pir * 16;
            f32x16 s0 = negm, s1 = negm;
#pragma unroll
            for (int d0 = 0; d0 < 4; ++d0) {
                const bf16x8 k0 = *(const LAS bf16x8*)(kb + d0 * 2048), k1 = *(const LAS bf16x8*)(kb + d0 * 2048 + 512);
                s0 = __builtin_amdgcn_mfma_f32_32x32x16_bf16(k0, qr[d0], s0, 0, 0, 0);
                s1 = __builtin_amdgcn_mfma_f32_32x32x16_bf16(k1, qr[d0], s1, 0, 0, 0);
            }
            float ps = 0.f;
#pragma unroll
            for (int r = 0; r < 16; ++r) { s0[r] = __builtin_amdgcn_exp2f(s0[r]); s1[r] = __builtin_amdgcn_exp2f(s1[r]); ps += s0[r] + s1[r]; }
            lsum += ps;
            v4u pw[4];
#pragma unroll
            for (int q = 0; q < 4; ++q) { pw[0][q] = cvt_pk_bf16(s0[2 * q], s0[2 * q + 1]); pw[1][q] = cvt_pk_bf16(s0[8 + 2 * q], s0[8 + 2 * q + 1]);
                pw[2][q] = cvt_pk_bf16(s1[2 * q], s1[2 * q + 1]); pw[3][q] = cvt_pk_bf16(s1[8 + 2 * q], s1[8 + 2 * q + 1]); }
#pragma unroll
            for (int vb = 0; vb < 4; ++vb) { const int dv = 32 * vb + r32; const LAS unsigned char* vp = lds + cur + AT_V + dv * 128; const int sw = (dv >> 1) & 7;
#pragma unroll
                for (int s = 0; s < 4; ++s) { const bf16x8 vf = *(const LAS bf16x8*)(vp + (((2 * s + hi) ^ sw) * 16));
                    o[vb] = __builtin_amdgcn_mfma_f32_32x32x16_bf16(vf, __builtin_bit_cast(bf16x8, pw[s]), o[vb], 0, 0, 0); } }
            if (tI + 1 < NTILE) {
#pragma unroll
                for (int i = 0; i < 2; ++i) { *(LAS v4u*)(lds + nxb + kdst[i]) = kreg[i]; *(LAS v4u*)(lds + nxb + vdst[i]) = vreg[i]; }
            }
            __syncthreads();
        }
        lsum += __shfl_xor(lsum, 32);
        const float inv = 1.0f / lsum;
        LAS float* ex = (LAS float*)lds + qg * 4096;
        if (map == 1) {
#pragma unroll
            for (int vb = 0; vb < 4; ++vb)
#pragma unroll
                for (int r = 0; r < 16; ++r) { const int dv = 32 * vb + (r & 3) + 8 * (r >> 2) + 4 * hi; ex[dv * 32 + r32] = o[vb][r] * inv; }
        }
        __syncthreads();
        if (map == 0) {
            float ss = 0.f;
#pragma unroll
            for (int vb = 0; vb < 4; ++vb)
#pragma unroll
                for (int r = 0; r < 16; ++r) { const int dv = 32 * vb + (r & 3) + 8 * (r >> 2) + 4 * hi; const float d = o[vb][r] * inv - lam * ex[dv * 32 + r32]; o[vb][r] = d; ss += d * d; }
            ss += __shfl_xor(ss, 32);
            const float rn = rsqrtf(ss * (1.0f / 128.0f) + 1e-5f) * 0.8f;
            bf16* orow = YD + ((size_t)b * T + qt * 128 + qg * 32 + r32) * 1024 + h * 128;
#pragma unroll
            for (int vb = 0; vb < 4; ++vb)
#pragma unroll
                for (int g4 = 0; g4 < 4; ++g4) { const int dv = 32 * vb + 8 * g4 + 4 * hi; const f32x4 sg = *(const f32x4*)(A.in[23] + dv);
                    v2u w; w.x = cvt_pk_bf16(o[vb][4 * g4] * rn * sg[0], o[vb][4 * g4 + 1] * rn * sg[1]); w.y = cvt_pk_bf16(o[vb][4 * g4 + 2] * rn * sg[2], o[vb][4 * g4 + 3] * rn * sg[3]);
                    *(GAS v2u*)(orow + dv) = w; }
        }
        __syncthreads();
    }
}

constexpr int LW_I1 = 32 * 64, LW_I2 = 16 * 32, LW_I3 = 32 * 32, LW_IE1 = 32 * 8 * 32, LW_IE2 = 8 * 32 * 32;
constexpr int LW_NIT = LW_I1 + 2 * LW_I2 + LW_I3 + 2 * LW_IE1 + LW_IE2;
__device__ __forceinline__ void latew_item(const Frame& F, const Args& A, int it, LAS float* scr, int lane) {
    bf16* WGT = (bf16*)(F.ws + WS_WGT); bf16* WPA = (bf16*)(F.ws + WS_WPA); bf16* WPB = (bf16*)(F.ws + WS_WPB); bf16* WOUT = (bf16*)(F.ws + WS_WOUT);
    bf16* E13 = (bf16*)((unsigned char*)A.out + OUT_EW13); bf16* E2 = (bf16*)((unsigned char*)A.out + OUT_EW2);
    int r = it;
    if (r < LW_I1) { tr_job64(r, A.in[8], NIN, 6784, 4096, WGT, 2048, 0, scr, lane); return; } r -= LW_I1;
    if (r < LW_I2) { tr_job64(r, A.in[24], 2048, 0, 2048, WPA, 1024, 0, scr, lane); return; } r -= LW_I2;
    if (r < LW_I2) { tr_job64(r, A.in[25], 2048, 0, 2048, WPB, 1024, 0, scr, lane); return; } r -= LW_I2;
    if (r < LW_I3) { tr_job64(r, A.in[26], 2048, 0, 2048, WOUT, 2048, 0, scr, lane); return; } r -= LW_I3;
    if (r < 2 * LW_IE1) {
        const int which = r >= LW_IE1 ? 1 : 0; if (which) r -= LW_IE1;
        const int e = r / 256, q = r - e * 256, kb = q >> 3, nb = q & 7, n0 = 64 * nb;
        const float* W = A.in[which ? 32 : 31] + (size_t)e * 2048 * 512;
        tr_item64(W, 512, n0, 64 * kb, E13, 2048, e * 1024 + (n0 >> 7) * 256 + which * 128 + (n0 & 127), scr, lane); return; }
    r -= 2 * LW_IE1;
    { const int e = r / 256, q = r - e * 256, kb = q >> 5, nb = q & 31;
      tr_item64(A.in[33] + (size_t)e * 512 * 2048, 2048, 64 * nb, 64 * kb, E2, 512, e * 2048 + 64 * nb, scr, lane); }
}

constexpr int A2_K = 0, A2_V = 65536, A2_SLOT = 16384, A2_SGL = 133120;
__device__ __forceinline__ void phase_attn2(const Frame& F, const Args& A) {
    const float* sm = (const float*)(F.ws + WS_SMALL);
    const bf16* P1 = (const bf16*)(F.ws + WS_P1); const bf16* Vt = (const bf16*)(F.ws + WS_VT); bf16* YD = (bf16*)(F.ws + WS_YD);
    const int lane = F.lane, wid = F.wave, r32 = lane & 31, hi = lane >> 5, map = wid & 1, qg = wid >> 1;
    const int pir = (r32 & 0x13) | ((r32 & 4) << 1) | ((r32 & 8) >> 1);
    LAS unsigned char* lds = F.lds;
    __syncthreads();
    if (F.tid < 128) ((LAS float*)(lds + A2_SGL))[F.tid] = A.in[23][F.tid];
    unsigned voffK0, voffV0;
    { const int p = 2 * wid;
        { const int key = 4 * p + (lane >> 4), pos = lane & 15, c = pos ^ (key & 15); voffK0 = (unsigned)(key * P1LD + c * 8) * 2u; }
        { const int dv = 8 * p + (lane >> 3), pos = lane & 7, c = pos ^ ((dv >> 1) & 7); voffV0 = (unsigned)(dv * TE + c * 8) * 2u; } }
    const f32x16 negm = {0.f, 0.f, 0.f, 0.f, 0.f, 0.f, 0.f, 0.f, 0.f, 0.f, 0.f, 0.f, 0.f, 0.f, 0.f, 0.f};
    const int koff = pir * 256, ksw = pir & 15;
    const int vrow = r32 * 128, vsw = (r32 >> 1) & 7;
    const int kad0 = A2_K + koff + (((map * 8 + hi) ^ ksw) * 16), vad0 = A2_V + vrow + ((hi ^ vsw) * 16);
    constexpr int NT = TE / 64;
#define A2_DMA_K(t_) do { const char* base_ = (const char*)(Kg + (size_t)(t_) * 64 * P1LD); const int dst_ = A2_K + ((t_) & 3) * A2_SLOT + wid * 2048; \
        __builtin_amdgcn_global_load_lds((const unsigned*)(base_ + voffK0), (LAS unsigned*)(lds + dst_), 16, 0, 0); \
        __builtin_amdgcn_global_load_lds((const unsigned*)(base_ + ((voffK0 ^ 64u) + 4u * P1LD * 2u)), (LAS unsigned*)(lds + dst_ + 1024), 16, 0, 0); } while (0)
#define A2_DMA_V(t_) do { const char* base_ = (const char*)(Vg + (size_t)(t_) * 64); const int dst_ = A2_V + ((t_) % 3) * A2_SLOT + wid * 2048; \
        __builtin_amdgcn_global_load_lds((const unsigned*)(base_ + voffV0), (LAS unsigned*)(lds + dst_), 16, 0, 0); \
        __builtin_amdgcn_global_load_lds((const unsigned*)(base_ + ((voffV0 ^ 64u) + 8u * TE * 2u)), (LAS unsigned*)(lds + dst_ + 1024), 16, 0, 0); } while (0)
#define A2_SB() __builtin_amdgcn_sched_barrier(0)
#define A2_KF(t_, d0_, blk_) (*(const LAS bf16x8*)(lds + (((t_) & 3) * A2_SLOT + (kad0 ^ ((d0_) << 5))) + (blk_) * 8192))
#define A2_VF(t_, s_, vb_) (*(const LAS bf16x8*)(lds + (((t_) % 3) * A2_SLOT + (vad0 ^ ((s_) << 5))) + (vb_) * 4096))
    unsigned* attcnt = (unsigned*)(F.ws + WS_CTL) + CW_ATT;
    volatile LAS unsigned* unw = (volatile LAS unsigned*)(lds + LDSCTL_OFF + 256);
    for (;;) {
        __syncthreads();
        if (F.tid == 0) {
            unsigned x = xb_xcc_id() & 7u, got = 0xffffffffu;
            for (int tr = 0; tr < 8; ++tr) { const unsigned li = __hip_atomic_fetch_add(attcnt + 128 + 64 * x, 1u, RLX_AGENT); if (li < 256u) { got = (x << 8) | li; break; } x = (x + 1u) & 7u; }
            unw[0] = got; }
        __syncthreads();
        const unsigned ug = unw[0];
        if (ug == 0xffffffffu) break;
        const int qt = (int)(ug & 63u), h = (int)(ug >> 8), b = (int)((ug >> 6) & 3u);
        const bf16* Kg = P1 + (size_t)b * TE * P1LD + PK + h * 128;
        const bf16* Vg = Vt + ((size_t)b * 1024 + h * 128) * TE;
        __syncthreads();
        A2_DMA_K(0); A2_DMA_V(0); A2_DMA_K(1); A2_DMA_K(2);
        const size_t erow = (size_t)b * TE + CTXL + qt * 128 + qg * 32 + r32;
        bf16x8 qr[4];
#pragma unroll
        for (int d0 = 0; d0 < 4; ++d0) qr[d0] = *(const GAS bf16x8*)(P1 + erow * P1LD + PQ + h * 128 + map * 64 + d0 * 16 + hi * 8);
        f32x16 o[4];
#pragma unroll
        for (int vb = 0; vb < 4; ++vb)
#pragma unroll
            for (int r = 0; r < 16; ++r) o[vb][r] = 0.f;
        float lsum = 0.f;
        __builtin_amdgcn_s_waitcnt(0);
        __builtin_amdgcn_s_barrier(); asm volatile("" ::: "memory");
        f32x16 c0, c1; v4u pw[4];
        A2_DMA_K(3); A2_DMA_V(1);
        c0 = __builtin_amdgcn_mfma_f32_32x32x16_bf16(A2_KF(0, 0, 0), qr[0], negm, 0, 0, 0); c1 = __builtin_amdgcn_mfma_f32_32x32x16_bf16(A2_KF(0, 0, 1), qr[0], negm, 0, 0, 0);
#pragma unroll
        for (int d0 = 1; d0 < 4; ++d0) { c0 = __builtin_amdgcn_mfma_f32_32x32x16_bf16(A2_KF(0, d0, 0), qr[d0], c0, 0, 0, 0); c1 = __builtin_amdgcn_mfma_f32_32x32x16_bf16(A2_KF(0, d0, 1), qr[d0], c1, 0, 0, 0); }
#pragma unroll
        for (int q = 0; q < 8; ++q) { const float e0 = __builtin_amdgcn_exp2f(c0[2 * q]), e1 = __builtin_amdgcn_exp2f(c0[2 * q + 1]), e2 = __builtin_amdgcn_exp2f(c1[2 * q]), e3 = __builtin_amdgcn_exp2f(c1[2 * q + 1]);
            lsum += (e0 + e1) + (e2 + e3); pw[q >> 2][q & 3] = cvt_pk_bf16(e0, e1); pw[2 + (q >> 2)][q & 3] = cvt_pk_bf16(e2, e3); }
        bf16x8 k0_ = A2_KF(1, 0, 0), k1_ = A2_KF(1, 0, 1), k2_ = A2_KF(1, 1, 0), k3_ = A2_KF(1, 1, 1);
        asm volatile("s_waitcnt vmcnt(4) lgkmcnt(0)" ::: "memory"); __builtin_amdgcn_s_barrier(); asm volatile("" ::: "memory");
#define A2_MF(C, KFR, Q, CIN) C = __builtin_amdgcn_mfma_f32_32x32x16_bf16(KFR, Q, CIN, 0, 0, 0)
#define A2_PVG(VR, OV, PWO, X, B2, PWN, H) do { OV = __builtin_amdgcn_mfma_f32_32x32x16_bf16(VR, __builtin_bit_cast(bf16x8, PWO), OV, 0, 0, 0); \
            { const float e0_ = __builtin_amdgcn_exp2f(X[(B2)]), e1_ = __builtin_amdgcn_exp2f(X[(B2) + 1]); sacc2_ += (f32x2){e0_, e1_}; unsigned pk_ = cvt_pk_bf16(e0_, e1_); \
              asm volatile("" : "+v"(pk_), "+v"(sacc2_)); PWN[(H)] = pk_; } } while (0)
        for (int t = 1; t < NT; ++t) {
            int nissue_ = 0;
            bf16x8 k4_, k5_, k6_, k7_, v0_, v1_, v2_, v3_;
            A2_MF(c0, k0_, qr[0], negm); k4_ = A2_KF(t, 2, 0); A2_SB();
            A2_MF(c1, k1_, qr[0], negm); k5_ = A2_KF(t, 2, 1); A2_SB();
            A2_MF(c0, k2_, qr[1], c0);   k6_ = A2_KF(t, 3, 0); A2_SB();
            A2_MF(c1, k3_, qr[1], c1);   k7_ = A2_KF(t, 3, 1); A2_SB();
            A2_MF(c0, k4_, qr[2], c0);   v0_ = A2_VF(t - 1, 0, 0); A2_SB();
            A2_MF(c1, k5_, qr[2], c1);   v1_ = A2_VF(t - 1, 0, 1); A2_SB();
            A2_MF(c0, k6_, qr[3], c0);   v2_ = A2_VF(t - 1, 0, 2); A2_SB();
            A2_MF(c1, k7_, qr[3], c1);   v3_ = A2_VF(t - 1, 0, 3); A2_SB();
            if (t + 3 < NT) { A2_DMA_K(t + 3); nissue_ += 2; } if (t + 1 < NT) { A2_DMA_V(t + 1); nissue_ += 2; } A2_SB();
            v4u pn0_, pn1_, pn2_, pn3_; f32x2 sacc2_ = {0.f, 0.f};
            A2_PVG(v0_, o[0], pw[0], c0, 0, pn0_, 0);  A2_SB();
            A2_PVG(v1_, o[1], pw[0], c0, 2, pn0_, 1);  v0_ = A2_VF(t - 1, 1, 0); A2_SB();
            A2_PVG(v2_, o[2], pw[0], c0, 4, pn0_, 2);  v1_ = A2_VF(t - 1, 1, 1); A2_SB();
            A2_PVG(v3_, o[3], pw[0], c0, 6, pn0_, 3);  v2_ = A2_VF(t - 1, 1, 2); A2_SB();
            A2_PVG(v0_, o[0], pw[1], c0, 8, pn1_, 0);  v3_ = A2_VF(t - 1, 1, 3); A2_SB();
            A2_PVG(v1_, o[1], pw[1], c0, 10, pn1_, 1); v0_ = A2_VF(t - 1, 2, 0); A2_SB();
            A2_PVG(v2_, o[2], pw[1], c0, 12, pn1_, 2); v1_ = A2_VF(t - 1, 2, 1); A2_SB();
            A2_PVG(v3_, o[3], pw[1], c0, 14, pn1_, 3); v2_ = A2_VF(t - 1, 2, 2); A2_SB();
            A2_PVG(v0_, o[0], pw[2], c1, 0, pn2_, 0);  v3_ = A2_VF(t - 1, 2, 3); A2_SB();
            A2_PVG(v1_, o[1], pw[2], c1, 2, pn2_, 1);  v0_ = A2_VF(t - 1, 3, 0); A2_SB();
            A2_PVG(v2_, o[2], pw[2], c1, 4, pn2_, 2);  v1_ = A2_VF(t - 1, 3, 1); A2_SB();
            A2_PVG(v3_, o[3], pw[2], c1, 6, pn2_, 3);  v2_ = A2_VF(t - 1, 3, 2); A2_SB();
            A2_PVG(v0_, o[0], pw[3], c1, 8, pn3_, 0);  v3_ = A2_VF(t - 1, 3, 3); A2_SB();
            A2_PVG(v1_, o[1], pw[3], c1, 10, pn3_, 1); if (t + 1 < NT) { k0_ = A2_KF(t + 1, 0, 0); k1_ = A2_KF(t + 1, 0, 1); } A2_SB();
            A2_PVG(v2_, o[2], pw[3], c1, 12, pn3_, 2); if (t + 1 < NT) { k2_ = A2_KF(t + 1, 1, 0); k3_ = A2_KF(t + 1, 1, 1); } A2_SB();
            A2_PVG(v3_, o[3], pw[3], c1, 14, pn3_, 3); A2_SB();
            lsum += sacc2_.x + sacc2_.y; pw[0] = pn0_; pw[1] = pn1_; pw[2] = pn2_; pw[3] = pn3_;
            if (nissue_ == 4) asm volatile("s_waitcnt vmcnt(4) lgkmcnt(0)" ::: "memory"); else if (nissue_ == 2) asm volatile("s_waitcnt vmcnt(2) lgkmcnt(0)" ::: "memory"); else asm volatile("s_waitcnt vmcnt(0) lgkmcnt(0)" ::: "memory");
            __builtin_amdgcn_s_barrier(); asm volatile("" ::: "memory");
        }
#pragma unroll
        for (int s = 0; s < 4; ++s)
#pragma unroll
            for (int vb = 0; vb < 4; ++vb) o[vb] = __builtin_amdgcn_mfma_f32_32x32x16_bf16(A2_VF(NT - 1, s, vb), __builtin_bit_cast(bf16x8, pw[s]), o[vb], 0, 0, 0);
        lsum += __shfl_xor(lsum, 32);
        const float inv = 1.0f / lsum;
        asm volatile("s_waitcnt lgkmcnt(0)" ::: "memory"); __builtin_amdgcn_s_barrier(); asm volatile("" ::: "memory");
        LAS float* ex = (LAS float*)lds + qg * 4096;
        if (map == 1) {
#pragma unroll
            for (int vb = 0; vb < 4; ++vb)
#pragma unroll
                for (int r = 0; r < 16; ++r) { const int dv = 32 * vb + (r & 3) + 8 * (r >> 2) + 4 * hi; ex[dv * 32 + r32] = o[vb][r] * inv; }
        }
        asm volatile("s_waitcnt lgkmcnt(0)" ::: "memory"); __builtin_amdgcn_s_barrier(); asm volatile("" ::: "memory");
        if (map == 0) {
            const float lam = sm[SM_MISC + 0];
            float ss = 0.f;
#pragma unroll
            for (int vb = 0; vb < 4; ++vb) {
#pragma unroll
                for (int r = 0; r < 16; ++r) { const int dv = 32 * vb + (r & 3) + 8 * (r >> 2) + 4 * hi; const float d = o[vb][r] * inv - lam * ex[dv * 32 + r32]; o[vb][r] = d; ss += d * d; }
                asm volatile("" : "+v"(ss), "+v"(o[vb])); A2_SB(); }
            ss += __shfl_xor(ss, 32);
            const float rn = rsqrtf(ss * (1.0f / 128.0f) + 1e-5f) * 0.8f;
            bf16* orow = YD + ((size_t)b * T + qt * 128 + qg * 32 + r32) * 1024 + h * 128;
#pragma unroll
            for (int vb = 0; vb < 4; ++vb)
#pragma unroll
                for (int g4 = 0; g4 < 4; ++g4) { const int dv = 32 * vb + 8 * g4 + 4 * hi; const f32x4 sg = *(const LAS f32x4*)(lds + A2_SGL + dv * 4);
                    v2u w; w.x = cvt_pk_bf16(o[vb][4 * g4] * rn * sg[0], o[vb][4 * g4 + 1] * rn * sg[1]); w.y = cvt_pk_bf16(o[vb][4 * g4 + 2] * rn * sg[2], o[vb][4 * g4 + 3] * rn * sg[3]);
                    *(GAS v2u*)(orow + dv) = w; }
        }
    }
    asm volatile("s_waitcnt vmcnt(0) lgkmcnt(0)" ::: "memory");
    __syncthreads();
    { unsigned* cvcnt = attcnt + 64; LAS float* scr = (LAS float*)(lds + wid * 16640);
      for (;;) {
          __syncthreads();
          if (F.tid == 0) unw[0] = __hip_atomic_fetch_add(cvcnt, 16u, RLX_AGENT);
          __syncthreads();
          const int it0 = (int)unw[0];
          if (it0 >= LW_NIT) break;
          { const int it = it0 + wid; if (it < LW_NIT) latew_item(F, A, it, scr, lane); }
          { const int it = it0 + 8 + wid; if (it < LW_NIT) latew_item(F, A, it, scr, lane); }
      } }
    asm volatile("s_waitcnt vmcnt(0) lgkmcnt(0)" ::: "memory");
    __syncthreads();
#undef A2_DMA_K
#undef A2_DMA_V
#undef A2_SB
#undef A2_KF
#undef A2_VF
#undef A2_MF
#undef A2_PVG
}

struct SchedSimple {
    const char* a; const char* b; size_t astep, bstep; int nM, nN, ntk, G, c;
    __device__ __forceinline__ bool next(int i, Unit& u) const { const int L = i * G + c; if (L >= nM * nN) return false; u.kind = 0; pg8::tile_order(L, nM, nN, u.pm, u.pn); return true; }
    __device__ __forceinline__ const char* a_ptr(const Unit& u) const { return a + (size_t)u.pm * astep; }
    __device__ __forceinline__ const char* b_ptr(const Unit& u) const { return b + (size_t)u.pn * bstep; }
    __device__ __forceinline__ int nt(const Unit&) const { return ntk; }
    __device__ __forceinline__ bool keep(const Unit&) const { return false; }
};
template <int MODE> struct EpiMerge {
    bf16* gate; bf16* mix; const float* x; float* out; const float* mod;
    __device__ __forceinline__ void operator()(const f32x4 (&acc)[2][2][4][2], const Unit& u, int wr, int wc, int fr, int fq) const {
        const int row0 = u.pm * 256 + wr * 64 + fr, col0 = u.pn * 256 + wc * 32 + 8 * fq;
#pragma unroll
        for (int ai = 0; ai < 2; ++ai)
#pragma unroll
            for (int m = 0; m < 4; ++m) { const size_t row = (size_t)(row0 + ai * 128 + m * 16);
#pragma unroll
                for (int bj = 0; bj < 2; ++bj) { const int col = col0 + bj * 128; const f32x4 v0 = acc[ai][bj][m][0], v1 = acc[ai][bj][m][1];
                    float v[8] = {v0[0], v0[1], v0[2], v0[3], v1[0], v1[1], v1[2], v1[3]};
                    if (MODE == 0) {
#pragma unroll
                        for (int q = 0; q < 8; ++q) v[q] = sigmoidf_(v[q]);
                        v4u w; w.x = cvt_pk_bf16(v[0], v[1]); w.y = cvt_pk_bf16(v[2], v[3]); w.z = cvt_pk_bf16(v[4], v[5]); w.w = cvt_pk_bf16(v[6], v[7]);
                        *(v4u*)(gate + row * 4096 + col) = w;
                    } else if (MODE == 1 || MODE == 2) {
                        const v4u g = *(const v4u*)(gate + row * 4096 + (MODE == 2 ? 2048 : 0) + col);
                        v4u t = {0u, 0u, 0u, 0u}; if (MODE == 2) t = *(const v4u*)(mix + row * 2048 + col);
                        v4u w;
#pragma unroll
                        for (int q = 0; q < 4; ++q) { const float a = bf2f(g[q] & 0xffffu) * v[2 * q] + bf2f(t[q] & 0xffffu), c = bf2f(g[q] >> 16) * v[2 * q + 1] + bf2f(t[q] >> 16); w[q] = cvt_pk_bf16(a, c); }
                        *(v4u*)(mix + row * 2048 + col) = w;
                    } else {
                        const int b = (int)(row >> 13);
                        const f32x4 x0 = *(const f32x4*)(x + row * 2048 + col), x1 = *(const f32x4*)(x + row * 2048 + col + 4);
                        const f32x4 g0 = *(const f32x4*)(mod + b * 12288 + 4096 + col), g1 = *(const f32x4*)(mod + b * 12288 + 4096 + col + 4);
                        const f32x4 y0 = x0 + g0 * v0, y1 = x1 + g1 * v1; v4u w; w.x = pk_f16(y0[0], y0[1]); w.y = pk_f16(y0[2], y0[3]); w.z = pk_f16(y1[0], y1[1]); w.w = pk_f16(y1[2], y1[3]);
                        *(v4u*)((unsigned short*)out + row * 2048 + col) = w;
                    }
                } }
    }
};

struct SchedGates {
    const char* hx; const char* wgt; int G, c;
    __device__ __forceinline__ bool next(int i, Unit& u) const { const int L = (i >> 1) * G + c; if (L >= 128 * 8) return false; u.kind = 0; pg8::tile_order(L, 128, 8, u.pm, u.pn); u.pn += 8 * (i & 1); return true; }
    __device__ __forceinline__ const char* a_ptr(const Unit& u) const { return hx + (size_t)(u.pm + (u.pm >> 5) + 1) * 256 * 2048 * 2; }
    __device__ __forceinline__ const char* b_ptr(const Unit& u) const { return wgt + (size_t)u.pn * 256 * 2048 * 2; }
    __device__ __forceinline__ int nt(const Unit&) const { return 32; }
    __device__ __forceinline__ bool keep(const Unit&) const { return false; }
};
struct SchedMerge2 {
    const char* yr; const char* yd; const char* wpa; const char* wpb; int G, c;
    __device__ __forceinline__ bool next(int i, Unit& u) const { const int L = (i >> 1) * G + c; if (L >= 128 * 8) return false; u.kind = i & 1; pg8::tile_order(L, 128, 8, u.pm, u.pn); return true; }
    __device__ __forceinline__ const char* a_ptr(const Unit& u) const { return (u.kind ? yd : yr) + (size_t)u.pm * 256 * 1024 * 2; }
    __device__ __forceinline__ const char* b_ptr(const Unit& u) const { return (u.kind ? wpb : wpa) + (size_t)u.pn * 256 * 1024 * 2; }
    __device__ __forceinline__ int nt(const Unit&) const { return 16; }
    __device__ __forceinline__ bool keep(const Unit& u) const { return u.kind == 0; }
};
constexpr int CW_PUB2 = 24576 + 64 * 320;
struct SchedOut {
    const char* a; const char* b; int G, c; volatile LAS unsigned* tab; const unsigned* pub;
    __device__ __forceinline__ bool next(int i, Unit& u) const {
        const int L = i * G + c; if (L >= 128 * 8) return false; u.kind = 0; pg8::tile_order(L, 128, 8, u.pm, u.pn);
        if (threadIdx.x < 64) {
            if (tab[381] == 0u) {
                const int pl = (int)(threadIdx.x & 63u);
                const int wg_ = (u.pm >> 3) * 64 + (pl & 7) * 8 + (u.pm & 7), Lp = (wg_ & 127) * 8 + (wg_ >> 7);
                const unsigned* fp = pl < 8 ? pub + 64 * (Lp % G) : pub + 64 * 256;
                unsigned sp = 0, fv;
                for (;;) { fv = __hip_atomic_load(fp, RLX_AGENT); if (__builtin_amdgcn_ballot_w64(pl < 8 && fv == 0u) == 0ull) break; __builtin_amdgcn_s_sleep(2); if (++sp > (1u << 22)) break; }
                const unsigned gd = (unsigned)__builtin_amdgcn_readlane((int)fv, 8);
                __builtin_amdgcn_fence(__ATOMIC_ACQUIRE, "agent");
                asm volatile("s_waitcnt vmcnt(0)" ::: "memory");
                if (gd >= (unsigned)G && threadIdx.x == 0) tab[381] = 1u;
            }
        }
        asm volatile("" ::: "memory"); __builtin_amdgcn_s_barrier(); asm volatile("" ::: "memory");
        return true;
    }
    __device__ __forceinline__ const char* a_ptr(const Unit& u) const { return a + (size_t)u.pm * 256 * 2048 * 2; }
    __device__ __forceinline__ const char* b_ptr(const Unit& u) const { return b + (size_t)u.pn * 256 * 2048 * 2; }
    __device__ __forceinline__ int nt(const Unit&) const { return 32; }
    __device__ __forceinline__ bool keep(const Unit&) const { return false; }
};
struct EpiMerge12 {
    const bf16* gate; bf16* mix;
    __device__ __forceinline__ void operator()(f32x4 (&acc)[2][2][4][2], const Unit& u, int wr, int wc, int fr, int fq) const {
        const int row0 = u.pm * 256 + wr * 64 + fr, col0 = u.pn * 256 + wc * 32 + 8 * fq;
#pragma unroll
        for (int ai = 0; ai < 2; ++ai)
#pragma unroll
            for (int m = 0; m < 4; ++m) { const size_t row = (size_t)(row0 + ai * 128 + m * 16);
#pragma unroll
                for (int bj = 0; bj < 2; ++bj) { const int col = col0 + bj * 128;
                    const v4u gb = *(const v4u*)(gate + row * 4096 + 2048 + col);
                    if (u.kind == 0) {
                        const v4u ga = *(const v4u*)(gate + row * 4096 + col);
#pragma unroll
                        for (int q = 0; q < 4; ++q) { const float r0 = bf2f(ga[q] & 0xffffu) * __builtin_amdgcn_rcpf(fmaxf(bf2f(gb[q] & 0xffffu), 1e-30f)), r1 = bf2f(ga[q] >> 16) * __builtin_amdgcn_rcpf(fmaxf(bf2f(gb[q] >> 16), 1e-30f));
                            acc[ai][bj][m][q >> 1][2 * (q & 1)] *= r0; acc[ai][bj][m][q >> 1][2 * (q & 1) + 1] *= r1; }
                    } else {
                        v4u w;
#pragma unroll
                        for (int q = 0; q < 4; ++q) w[q] = cvt_pk_bf16(acc[ai][bj][m][q >> 1][2 * (q & 1)] * bf2f(gb[q] & 0xffffu), acc[ai][bj][m][q >> 1][2 * (q & 1) + 1] * bf2f(gb[q] >> 16));
                        *(v4u*)(mix + row * 2048 + col) = w;
                    }
                } }
    }
};

__device__ __forceinline__ void phase_router2(const Frame& F, const Args& A, const int pr = 0) {
    const float* sm = (const float*)(F.ws + WS_SMALL);
    bf16* H2 = (bf16*)(F.ws + WS_H2);
    unsigned* cnt = (unsigned*)(F.ws + WS_CTL) + CW_CNT + (pr ? 32 : 0);
    unsigned* tokrec = (unsigned*)(F.ws + WS_TOK + (pr ? MiB : 0));
    const int lane = F.lane; const unsigned lo16 = (unsigned)lane * 16u;
    if (F.bid == 0) for (int i = F.tid; i < D / 2; i += 512) ((unsigned*)(H2 + (size_t)ML * D))[i] = 0u;
    unsigned* elist = (unsigned*)(F.ws + WS_GOFF) + (pr ? (size_t)NE * ML : 0);
    __syncthreads();
    { const GAS v4u* src = (const GAS v4u*)(sm + SM_WET) + F.tid; LAS v4u* dst = (LAS v4u*)F.lds + F.tid;
#pragma unroll
      for (int it = 0; it < 16; ++it) dst[512 * it] = src[512 * it]; }
    __syncthreads();
    const float* wg = sm + SM_WRT;
    for (int m = F.gw; m < ML; m += F.ngw) {
        const int b = m / T;
        const float* mod = sm + SM_MOD + b * 12288;
        const GAS v2u* xr = (const GAS v2u*)((const unsigned short*)(F.ws + WS_XN) + (size_t)m * D) + lane;
        f32x4 v[8]; float s = 0.f;
#pragma unroll
        for (int q = 0; q < 8; ++q) { const v2u xh = xr[64 * q]; v[q] = (f32x4){f16lo(xh.x), f16hi(xh.x), f16lo(xh.y), f16hi(xh.y)}; s += (v[q].x * v[q].x + v[q].y * v[q].y) + (v[q].z * v[q].z + v[q].w * v[q].w); }
        const float rstd = rsqrtf(wave_sum(s) * (1.0f / D) + 1e-6f);
        GAS v2u* o8 = (GAS v2u*)(H2 + (size_t)m * D) + lane;
        float gl[4] = {0.f, 0.f, 0.f, 0.f};
#pragma unroll
        for (int q = 0; q < 8; ++q) {
            const f32x4 g = *(const f32x4*)((const char*)A.in[7] + lo16 + q * 1024), sh = *(const f32x4*)((const char*)(mod + 3 * 2048) + lo16 + q * 1024), sc = *(const f32x4*)((const char*)(mod + 4 * 2048) + lo16 + q * 1024);
            v[q] = v[q] * rstd * g * (sc + 1.0f) + sh;
            v2u w; w.x = cvt_pk_bf16(v[q].x, v[q].y); w.y = cvt_pk_bf16(v[q].z, v[q].w); o8[64 * q] = w;
#pragma unroll
            for (int n = 0; n < 4; ++n) { const f32x4 w4 = *(const f32x4*)((const char*)(wg + n * 2048) + lo16 + q * 1024); gl[n] += (v[q].x * w4.x + v[q].y * w4.y) + (v[q].z * w4.z + v[q].w * w4.w); } }
#pragma unroll
        for (int n = 0; n < 4; ++n) gl[n] = wave_sum(gl[n]) + A.in[28][n];
        int gt = 0; float gm = gl[0];
#pragma unroll
        for (int i = 1; i < 4; ++i) if (gl[i] > gm) { gm = gl[i]; gt = i; }
        gt = __builtin_amdgcn_readfirstlane(gt);
        float gs = 0.f;
#pragma unroll
        for (int i = 0; i < 4; ++i) gs += __expf(gl[i] - gm);
        const float pg = 1.0f / gs;
        float el[8];
        const LAS unsigned char* wl = F.lds + (size_t)gt * 8 * 4096 + 8 * lane;
#pragma unroll
        for (int i = 0; i < 8; ++i) { float acc = 0.f;
#pragma unroll
            for (int q = 0; q < 8; ++q) { const v2u w = *(const LAS v2u*)(wl + i * 4096 + 512 * q);
                acc += (v[q].x * f16lo(w.x) + v[q].y * f16hi(w.x)) + (v[q].z * f16lo(w.y) + v[q].w * f16hi(w.y)); }
            asm volatile("" : "+v"(acc)); el[i] = acc; }
#pragma unroll
        for (int i = 0; i < 8; ++i) el[i] = wave_sum(el[i]);
        if (lane == 0) {
#pragma unroll
            for (int i = 0; i < 8; ++i) { const float b0 = A.in[30][i], b1 = A.in[30][8 + i], b2 = A.in[30][16 + i], b3 = A.in[30][24 + i]; el[i] += gt == 0 ? b0 : (gt == 1 ? b1 : (gt == 2 ? b2 : b3)); }
            int i1 = 0; float m1 = el[0];
#pragma unroll
            for (int i = 1; i < 8; ++i) if (el[i] > m1) { m1 = el[i]; i1 = i; }
            int i2 = -1; float m2 = -3.0e38f;
#pragma unroll
            for (int i = 0; i < 8; ++i) if (i != i1 && el[i] > m2) { m2 = el[i]; i2 = i; }
            const float w1 = 1.0f / (1.0f + __expf(m2 - m1)), w2 = 1.0f - w1;
            const int e0 = gt * 8 + i1, e1 = gt * 8 + i2;
            const unsigned p0 = __hip_atomic_fetch_add(cnt + e0 * CNT_STRIDE, 1u, RLX_AGENT), p1 = __hip_atomic_fetch_add(cnt + e1 * CNT_STRIDE, 1u, RLX_AGENT);
            v4u rec; rec.x = (unsigned)e0 | ((unsigned)e1 << 8); rec.y = p0 | (p1 << 16); rec.z = __float_as_uint(pg * w1); rec.w = __float_as_uint(pg * w2);
            *(GAS v4u*)(tokrec + (size_t)m * 4) = rec;
            elist[(size_t)e0 * ML + p0] = (unsigned)m; elist[(size_t)e1 * ML + p1] = (unsigned)m;
        }
    }
}

__device__ __forceinline__ void build_block_table(const Frame& F) {
    volatile LAS unsigned* tab = (volatile LAS unsigned*)(F.lds + LDSCTL_OFF);
    __syncthreads();
    if (F.tid == 0) {
        unsigned* cnt = (unsigned*)(F.ws + WS_CTL) + CW_CNT; unsigned st = 0;
        for (int e = 0; e < NE; ++e) { const unsigned c = __hip_atomic_load(cnt + e * CNT_STRIDE, RLX_AGENT); const unsigned nb = (c + 255u) >> 8; tab[1 + e] = st;
            for (unsigned q = 0; q < nb && st + q < CAPB; ++q) tab[40 + st + q] = e; st += nb; tab[340 + e] = c; }
        if (st > CAPB) st = CAPB;
        tab[33] = st; tab[0] = st;
    }
    __syncthreads();
}

__device__ __forceinline__ void phase_gather(const Frame& F, const Args& A) {
    build_block_table(F);
    volatile LAS unsigned* tab = (volatile LAS unsigned*)(F.lds + LDSCTL_OFF);
    unsigned* goff = (unsigned*)(F.ws + WS_GOFF);
    const unsigned* tokrec = (const unsigned*)(F.ws + WS_TOK);
    for (int m = F.bid * 512 + F.tid; m < ML; m += F.G * 512) {
        const v4u rec = *(const GAS v4u*)(tokrec + (size_t)m * 4);
        const unsigned e0 = rec.x & 0xffu, e1 = (rec.x >> 8) & 0xffu;
        const unsigned s0 = tab[1 + e0] * 256u + (rec.y & 0xffffu), s1 = tab[1 + e1] * 256u + (rec.y >> 16);
        const unsigned off = (unsigned)m * (unsigned)(D * 2);
        if (s0 < (unsigned)(CAPB * 256)) goff[s0] = off;
        if (s1 < (unsigned)(CAPB * 256)) goff[s1] = off;
    }
}

struct SchedMoe {
    const char* a; const char* b; size_t astep, bstep; int npn, ntk, G, c; volatile LAS unsigned* tab;
    __device__ __forceinline__ bool next(int i, Unit& u) const { const int L = i * G + c; const int nblk = (int)tab[0]; if (L >= nblk * npn) return false; u.pm = L / npn; u.pn = L - u.pm * npn; u.kind = (int)tab[40 + u.pm]; return true; }
    __device__ __forceinline__ const char* a_ptr(const Unit& u) const { return a + (size_t)u.pm * astep; }
    __device__ __forceinline__ const char* b_ptr(const Unit& u) const { return b + (size_t)(u.kind * npn + u.pn) * bstep; }
    __device__ __forceinline__ int nt(const Unit&) const { return ntk; }
    __device__ __forceinline__ bool keep(const Unit&) const { return false; }
    const unsigned* list;
    __device__ __forceinline__ unsigned goff(const Unit& u, int r) const { const unsigned e = (unsigned)u.kind, pos = ((unsigned)u.pm - tab[1 + e]) * 256u + (unsigned)r;
        return (pos < tab[340 + e] ? list[(size_t)e * ML + pos] : (unsigned)ML) * (unsigned)(D * 2); }
};
constexpr int CW_PUB = 24576;
struct SchedMoeDown {
    const char* a; const char* b; int G, c; volatile LAS unsigned* tab; unsigned* pub;
    __device__ __forceinline__ bool next(int i, Unit& u) const {
        const int nblk = (int)tab[0]; const int G4 = G >> 2, q15 = (4 * nblk) / G, r = (4 * nblk) - q15 * G, r4 = r >> 2, nl = G - r, nlb = G4 - r4, NLU = 8 * q15 * nlb;
        int P;
        if (c >= r) P = (i < 4) ? i * nl + (c - r) : 4 * nl + (i - 4) * G + c; else P = 4 * nl + i * G + c;
        if (P >= nblk * 8) return false;
        u.pn = P & 7;
        if (P < NLU) { const int lb = P >> 3, g = lb / nlb; u.pm = g * G4 + (lb - g * nlb) + r4; }
        else { const int hb = (P - NLU) >> 3, g = hb / (r4 > 0 ? r4 : 1); u.pm = g * G4 + (hb - g * r4); }
        u.kind = (int)tab[40 + u.pm];
        if (threadIdx.x < 64) {
            if (tab[380] == 0u) {
                const int pl = (int)(threadIdx.x & 63u);
                const unsigned* fp = pl < 4 ? pub + 64 * ((4 * u.pm + pl) % G) : pub + 64 * 300;
                unsigned sp = 0, fv;
                for (;;) { fv = __hip_atomic_load(fp, RLX_AGENT); if (__builtin_amdgcn_ballot_w64(pl < 4 && fv == 0u) == 0ull) break; __builtin_amdgcn_s_sleep(2); if (++sp > (1u << 22)) break; }
                const unsigned gd = (unsigned)__builtin_amdgcn_readlane((int)fv, 4);
                __builtin_amdgcn_fence(__ATOMIC_ACQUIRE, "agent");
                asm volatile("s_waitcnt vmcnt(0)" ::: "memory");
                if (gd >= (unsigned)G && threadIdx.x == 0) tab[380] = 1u;
            }
        }
        asm volatile("" ::: "memory"); __builtin_amdgcn_s_barrier(); asm volatile("" ::: "memory");
        return true;
    }
    __device__ __forceinline__ const char* a_ptr(const Unit& u) const { return a + (size_t)u.pm * 256 * 512 * 2; }
    __device__ __forceinline__ const char* b_ptr(const Unit& u) const { return b + (size_t)(u.kind * 8 + u.pn) * 256 * 512 * 2; }
    __device__ __forceinline__ int nt(const Unit&) const { return 8; }
    __device__ __forceinline__ bool keep(const Unit&) const { return false; }
};
struct EpiMoe1 {
    bf16* H;
    __device__ __forceinline__ void operator()(const f32x4 (&acc)[2][2][4][2], const Unit& u, int wr, int wc, int fr, int fq) const {
        const int row0 = u.pm * 256 + wr * 64 + fr, col0 = u.pn * 128 + wc * 32 + 8 * fq;
#pragma unroll
        for (int ai = 0; ai < 2; ++ai)
#pragma unroll
            for (int m = 0; m < 4; ++m) { const f32x4 a0 = acc[ai][0][m][0], a1 = acc[ai][0][m][1], b0 = acc[ai][1][m][0], b1 = acc[ai][1][m][1];
                float v[8];
#pragma unroll
                for (int q = 0; q < 4; ++q) { v[q] = a0[q] * sigmoidf_(a0[q]) * b0[q]; v[4 + q] = a1[q] * sigmoidf_(a1[q]) * b1[q]; }
                v4u w; w.x = cvt_pk_bf16(v[0], v[1]); w.y = cvt_pk_bf16(v[2], v[3]); w.z = cvt_pk_bf16(v[4], v[5]); w.w = cvt_pk_bf16(v[6], v[7]);
                *(v4u*)(H + (size_t)(row0 + ai * 128 + m * 16) * DE + col0) = w; }
    }
};
struct EpiMoe2 {
    bf16* Y;
    __device__ __forceinline__ void operator()(const f32x4 (&acc)[2][2][4][2], const Unit& u, int wr, int wc, int fr, int fq) const {
        const int row0 = u.pm * 256 + wr * 64 + fr, col0 = u.pn * 256 + wc * 32 + 8 * fq;
#pragma unroll
        for (int ai = 0; ai < 2; ++ai)
#pragma unroll
            for (int m = 0; m < 4; ++m)
#pragma unroll
                for (int bj = 0; bj < 2; ++bj) { const f32x4 v0 = acc[ai][bj][m][0], v1 = acc[ai][bj][m][1];
                    v4u w; w.x = cvt_pk_bf16(v0[0], v0[1]); w.y = cvt_pk_bf16(v0[2], v0[3]); w.z = cvt_pk_bf16(v1[0], v1[1]); w.w = cvt_pk_bf16(v1[2], v1[3]);
                    *(v4u*)(Y + (size_t)(row0 + ai * 128 + m * 16) * D + col0 + bj * 128) = w; }
    }
};

__device__ __forceinline__ void phase_final(const Frame& F, const Args& A, const int pr = 0) {
    build_block_table(F);
    volatile LAS unsigned* tab = (volatile LAS unsigned*)(F.lds + LDSCTL_OFF);
    const float* sm = (const float*)(F.ws + WS_SMALL);
    const bf16* Y = (const bf16*)(F.ws + WS_XG);
    const unsigned* tokrec = (const unsigned*)(F.ws + WS_TOK);
    for (int m = F.gw; m < ML; m += F.ngw) {
        const int b = m / T; const float* gt2 = sm + SM_MOD + b * 12288 + 5 * 2048;
        const v4u rec = *(const GAS v4u*)(tokrec + (size_t)m * 4);
        const unsigned e0 = rec.x & 0xffu, e1 = (rec.x >> 8) & 0xffu;
        const unsigned s0 = tab[1 + e0] * 256u + (rec.y & 0xffffu), s1 = tab[1 + e1] * 256u + (rec.y >> 16);
        const float g0 = __uint_as_float(rec.z), g1 = __uint_as_float(rec.w);
        GAS f32x4* o = (GAS f32x4*)(A.out + (size_t)m * D) + F.lane; const GAS v2u* xn = (const GAS v2u*)((const unsigned short*)(F.ws + WS_XN) + (size_t)m * D) + F.lane;
        const GAS v2u* y0 = (const GAS v2u*)(Y + (size_t)s0 * D) + F.lane; const GAS v2u* y1 = (const GAS v2u*)(Y + (size_t)s1 * D) + F.lane;
#pragma unroll
        for (int q = 0; q < 8; ++q) { const int c = 4 * F.lane + 256 * q; const f32x4 g = *(const f32x4*)(gt2 + c);
            const v2u a = y0[64 * q], bb = y1[64 * q]; const v2u xh = xn[64 * q]; const f32x4 x = {f16lo(xh.x), f16hi(xh.x), f16lo(xh.y), f16hi(xh.y)};
            const f32x4 mo = {g0 * bf2f(a.x & 0xffffu) + g1 * bf2f(bb.x & 0xffffu), g0 * bf2f(a.x >> 16) + g1 * bf2f(bb.x >> 16), g0 * bf2f(a.y & 0xffffu) + g1 * bf2f(bb.y & 0xffffu), g0 * bf2f(a.y >> 16) + g1 * bf2f(bb.y >> 16)};
            o[64 * q] = x + g * mo; }
    }
}

#ifndef DUPK
#define DUPK -1
#endif
constexpr int NPHASE = 17;
constexpr int REPS[18] = {1, 1, 1, 1, 1, 1, 1, 1, 1, 1, 1, 1, 1, 1, 1, 1, 1, 1};
__global__ void __launch_bounds__(512, 2) mk_fwd(Args args) {
    extern __shared__ __attribute__((aligned(16))) unsigned char lds_raw[];
    Frame F;
    F.lds = (LAS unsigned char*)lds_raw; F.ws = args.ws;
    F.tid = threadIdx.x; F.lane = F.tid & 63; F.wave = __builtin_amdgcn_readfirstlane(F.tid >> 6);
    F.G = gridDim.x; F.bid = blockIdx.x; F.gw = F.bid * 8 + F.wave; F.ngw = F.G * 8;
    for (int u = F.tid; u < (LDS_BYTES - LDSCTL_OFF) / 4; u += 512) ((LAS unsigned*)(F.lds + LDSCTL_OFF))[u] = 0u;
    __syncthreads();
    unsigned* ctl = (unsigned*)(F.ws + WS_CTL);
    XcdBarrier bar; bar.bar = ctl + CW_BAR; bar.x = 0; bar.st = nullptr;
#if !MK_PER_PHASE
    bar = xcd_barrier_post(ctl + CW_BAR, (volatile LAS unsigned*)(F.lds + MISC_OFF));
#endif
    const int lo = args.ph_lo, hi = args.ph_hi;
#ifndef PH_ENABLE
#define PH_ENABLE 0xFFFFFFFFu
#endif
#define IN(k) (((PH_ENABLE >> (k)) & 1u) && lo <= (k) && (k) < hi)
#if MK_PER_PHASE
#define SEAM(k) do { } while (0)
#else
#define SEAM(k) do { if (IN(k) && IN((k) + 1)) xcd_barrier(bar); } while (0)
#endif
    LAS unsigned char* ring = F.lds;
    if (IN(0)) { for (int rep_ = 0; rep_ < REPS[0]; ++rep_) { if (rep_) xcd_barrier(bar); phase_prologue(F, args); } }
    if (IN(0) && IN(1)) {
        if (F.tid < 64) { const unsigned* mp = (const unsigned*)(F.ws + WS_CTL) + CW_MODPUB; unsigned sp = 0;
            while ((unsigned)__builtin_amdgcn_readfirstlane((int)__hip_atomic_load(mp, __ATOMIC_RELAXED, __HIP_MEMORY_SCOPE_AGENT)) < (unsigned)F.G) { __builtin_amdgcn_s_sleep(2); if (++sp > (1u << 24)) break; }
            __builtin_amdgcn_fence(__ATOMIC_ACQUIRE, "agent"); asm volatile("s_waitcnt vmcnt(0)" ::: "memory"); }
        __syncthreads();
    }
    if (IN(1)) { for (int rep_ = 0; rep_ < REPS[1]; ++rep_) { if (rep_) xcd_barrier(bar); phase_hx<true>(F, args, (bf16*)(F.ws + WS_HX)); } } SEAM(1);
    if (IN(2)) { for (int rep_ = 0; rep_ < REPS[2]; ++rep_) { if (rep_) xcd_barrier(bar); SchedInproj S{(const char*)(F.ws + WS_HX), (const char*)(F.ws + WS_W1T), (const char*)(F.ws + WS_WVT), F.G, F.bid};
        EpiInproj E{(bf16*)(F.ws + WS_P1), (bf16*)(F.ws + WS_VT)};
        pg8::gemm_phase<EpiInproj, SchedInproj>(ring, 2048, 2048, S, E); } } SEAM(2);
    if (IN(3)) { phase_e1(F, args);
#if DUPK == 3
        xcd_barrier(bar); phase_e1(F, args, 1);
#endif
    } SEAM(3);
    if (IN(4)) { { SchedLora S{(const char*)(F.ws + WS_XL), (const char*)(F.ws + WS_LW), F.G, F.bid};
        EpiLora E{(unsigned short*)(F.ws + WS_LO), (bf16*)(F.ws + WS_G), args.in[10], args.in[12]};
        pg8::gemm_phase<EpiLora, SchedLora>(ring, XLLD, 256, S, E); }
#if DUPK == 4
        xcd_barrier(bar); { SchedLora S{(const char*)(F.ws + WS_XL), (const char*)(F.ws + WS_LW), F.G, F.bid};
        EpiLora E{(unsigned short*)(F.ws + WS_LO), (bf16*)(F.ws + WS_G), args.in[10], args.in[12]};
        pg8::gemm_phase<EpiLora, SchedLora>(ring, XLLD, 256, S, E); }
#endif
    } SEAM(4);
    if (IN(5)) { phase_scan(F, args);
        if (((const float*)(F.ws + WS_SMALL))[SM_MISC + 1] < 100.0f) phase_attn2(F, args);
        else { phase_attn(F, args); LAS float* scr = (LAS float*)(F.lds + F.wave * 16640); for (int it = F.gw; it < LW_NIT; it += F.ngw) latew_item(F, args, it, scr, F.lane); }
        phase_rcomb(F, args, 0, 1);
    } SEAM(5);
    const float* smod = (const float*)(F.ws + WS_SMALL) + SM_MOD;
    if (IN(9)) { for (int rep_ = 0; rep_ < REPS[9]; ++rep_) { if (rep_) xcd_barrier(bar); SchedGates S{(const char*)(F.ws + WS_HX), (const char*)(F.ws + WS_WGT), F.G, F.bid};
        EpiMerge<0> E{(bf16*)(F.ws + WS_GATE), (bf16*)(F.ws + WS_MIX), args.in[0], args.out, smod};
        pg8::gemm_phase<EpiMerge<0>, SchedGates>(ring, 2048, 2048, S, E); } }
    asm volatile("s_waitcnt vmcnt(0)" ::: "memory"); __syncthreads();
    if (IN(10)) { SchedMerge2 S{(const char*)args.out + OUT_YF, (const char*)(F.ws + WS_YD), (const char*)(F.ws + WS_WPA), (const char*)(F.ws + WS_WPB), F.G, F.bid};
        EpiMerge12 E{(const bf16*)(F.ws + WS_GATE), (bf16*)(F.ws + WS_MIX)};
        pg8::gemm_phase<EpiMerge12, SchedMerge2>(ring, 1024, 1024, S, E); }
    if (IN(10) && IN(12)) {
        asm volatile("s_waitcnt vmcnt(0) lgkmcnt(0)" ::: "memory"); __syncthreads();
        if (F.tid == 0) { unsigned* pub = (unsigned*)(F.ws + WS_CTL) + CW_PUB2;
            __builtin_amdgcn_fence(__ATOMIC_RELEASE, "agent"); asm volatile("s_waitcnt vmcnt(0)" ::: "memory");
            (void)__hip_atomic_fetch_add(pub + 64 * F.bid, 1u, RLX_AGENT); (void)__hip_atomic_fetch_add(pub + 64 * 256, 1u, RLX_AGENT); }
        __syncthreads();
    }
    if (IN(12)) { for (int rep_ = 0; rep_ < REPS[12]; ++rep_) { if (rep_) xcd_barrier(bar); SchedOut S{(const char*)(F.ws + WS_MIX), (const char*)(F.ws + WS_WOUT), F.G, F.bid, (volatile LAS unsigned*)(F.lds + LDSCTL_OFF), (const unsigned*)(F.ws + WS_CTL) + CW_PUB2};
        EpiMerge<3> E{(bf16*)(F.ws + WS_GATE), (bf16*)(F.ws + WS_MIX), args.in[0], (float*)(F.ws + WS_XN), smod};
        pg8::gemm_phase<EpiMerge<3>, SchedOut>(ring, 2048, 2048, S, E); } } SEAM(12);
    if (IN(13)) { phase_router2(F, args);
#if DUPK == 13
        xcd_barrier(bar); phase_router2(F, args, 1);
#endif
    } SEAM(13);
    if (IN(15)) { build_block_table(F);
        { SchedMoe S{(const char*)(F.ws + WS_H2), (const char*)args.out + OUT_EW13, (size_t)0, (size_t)256 * 2048 * 2, 4, 32, F.G, F.bid, (volatile LAS unsigned*)(F.lds + LDSCTL_OFF), (const unsigned*)(F.ws + WS_GOFF)};
          EpiMoe1 E{(bf16*)(F.ws + WS_HM)};
          pg8::gemm_phase<EpiMoe1, SchedMoe, true>(ring, 2048, 2048, S, E); }
        asm volatile("s_waitcnt vmcnt(0) lgkmcnt(0)" ::: "memory"); __syncthreads();
        if (F.tid == 0) { unsigned* pub = (unsigned*)(F.ws + WS_CTL) + CW_PUB;
            __builtin_amdgcn_fence(__ATOMIC_RELEASE, "agent"); asm volatile("s_waitcnt vmcnt(0)" ::: "memory");
            (void)__hip_atomic_fetch_add(pub + 64 * F.bid, 1u, RLX_AGENT); (void)__hip_atomic_fetch_add(pub + 64 * 300, 1u, RLX_AGENT);
            ((volatile LAS unsigned*)(F.lds + LDSCTL_OFF))[380] = 0u; }
        __syncthreads();
        { SchedMoeDown S{(const char*)(F.ws + WS_HM), (const char*)args.out + OUT_EW2, F.G, F.bid, (volatile LAS unsigned*)(F.lds + LDSCTL_OFF), (unsigned*)(F.ws + WS_CTL) + CW_PUB};
          EpiMoe2 E{(bf16*)(F.ws + WS_XG)};
          pg8::gemm_phase<EpiMoe2, SchedMoeDown>(ring, 512, 512, S, E); }
    } SEAM(15);
    if (IN(17)) { phase_final(F, args);
#if DUPK == 17
        xcd_barrier(bar); phase_final(F, args, 1);
#endif
    }
#undef IN
#undef SEAM
}

extern "C" void kernel_launch(void* const* d_in, const int* in_sizes, int n_in, void* d_out, int out_size, void* d_ws, size_t ws_size, hipStream_t stream) {
    static int grid = 0;
    if (grid == 0) {
        if (n_in != 34 || out_size != ML * D || ws_size < WS_NEED) { fprintf(stderr, "kernel_launch: unexpected problem (n_in %d out %d ws %zu)\n", n_in, out_size, ws_size); grid = -1; return; }
        int dev = 0, cus = 0, per_cu = 0;
        if (hipGetDevice(&dev) != hipSuccess || hipDeviceGetAttribute(&cus, hipDeviceAttributeMultiprocessorCount, dev) != hipSuccess) { grid = -1; return; }
        if (hipFuncSetAttribute((const void*)mk_fwd, hipFuncAttributeMaxDynamicSharedMemorySize, LDS_BYTES) != hipSuccess) { fprintf(stderr, "kernel_launch: hipFuncSetAttribute failed\n"); grid = -1; return; }
        if (hipOccupancyMaxActiveBlocksPerMultiprocessor(&per_cu, (const void*)mk_fwd, 512, LDS_BYTES) != hipSuccess || per_cu < 1) fprintf(stderr, "kernel_launch: occupancy query says %d\n", per_cu);
        (void)hipGetLastError();
        grid = cus;
    }
    if (grid < 0) return;
    if (hipMemsetAsync((char*)d_ws + WS_CTL, 0, CTL_ZERO_BYTES, stream) != hipSuccess) return;
    Args a{};
    for (int i = 0; i < 34; ++i) a.in[i] = (const float*)d_in[i];
    a.out = (float*)d_out; a.ws = (unsigned char*)d_ws;
#if MK_PER_PHASE
    for (int p = 0; p <= NPHASE; ++p) { a.ph_lo = p; a.ph_hi = p + 1; hipLaunchKernelGGL(mk_fwd, dim3(grid), dim3(512), LDS_BYTES, stream, a); }
#else
    a.ph_lo = 0; a.ph_hi = NPHASE + 1;
    hipLaunchKernelGGL(mk_fwd, dim3(grid), dim3(512), LDS_BYTES, stream, a);
#endif
}
```

```cpp
#include <hip/hip_runtime.h>
#include <cstdio>
#include <cstdint>

#ifndef MK_PER_PHASE
#define MK_PER_PHASE 0
#endif

#define GAS __attribute__((address_space(1)))
#define LAS __attribute__((address_space(3)))
typedef unsigned short bf16;
typedef unsigned v4u __attribute__((ext_vector_type(4)));
typedef unsigned v2u __attribute__((ext_vector_type(2)));
typedef float f32x4 __attribute__((ext_vector_type(4)));
typedef float f32x2 __attribute__((ext_vector_type(2)));
typedef float f32x16 __attribute__((ext_vector_type(16)));
typedef short bf16x8 __attribute__((ext_vector_type(8)));
typedef GAS unsigned gu32;
#define RLX_AGENT __ATOMIC_RELAXED, __HIP_MEMORY_SCOPE_AGENT
#define LDS_WAIT() asm volatile("s_waitcnt lgkmcnt(0)" ::: "memory")
#define VM_WAIT() asm volatile("s_waitcnt vmcnt(0)" ::: "memory")

constexpr int D = 2048, NB = 4, T = 8192, CTXL = 256, TE = T + CTXL;
constexpr int ME = NB * TE, ML = NB * T;
constexpr int RC = 1024, RH = 16, RN = 64;
constexpr int NIN = 10880, RWKV_COLS = 3712;
constexpr int P1LD = 5888, PQ = 3840, PK = 4864;
constexpr int XLLD = 768;
constexpr int NE = 32, DE = 512, CAPB = 288;
constexpr float C2 = 0.125f * 1.4426950408889634f;

constexpr size_t MiB = 1u << 20;
constexpr size_t WS_CTL = 0, CTL_ZERO_BYTES = 512 * 1024;
constexpr size_t WS_SMALL = 256 * 1024;
constexpr size_t WS_LW = 1 * MiB;
constexpr size_t WS_HX = 4 * MiB;
constexpr size_t OUT_YF = 192 * MiB;
constexpr size_t WS_YB = 844 * MiB;
constexpr size_t WS_W1T = 136 * MiB, WS_WVT = 159 * MiB;
constexpr size_t WS_XL = 136 * MiB;
constexpr size_t WS_YD = 136 * MiB;
constexpr size_t WS_P1 = 200 * MiB;
constexpr size_t WS_VT = 580 * MiB;
constexpr size_t WS_LO = 646 * MiB;
constexpr size_t WS_G = 910 * MiB;
constexpr size_t WS_END1 = 976 * MiB;
constexpr size_t WS_WGT = 976 * MiB, WS_WPA = 992 * MiB, WS_WPB = 996 * MiB, WS_WOUT = 1000 * MiB;
constexpr size_t WS_HX2 = 646 * MiB;
constexpr size_t WS_GATE = 360 * MiB;
constexpr size_t WS_MIX = 616 * MiB;
constexpr size_t OUT_EW13 = 0, OUT_EW2 = 128 * MiB;
constexpr size_t WS_XN = 744 * MiB;
constexpr size_t WS_H2 = 4 * MiB;
constexpr size_t WS_XG = 200 * MiB;
constexpr size_t WS_HM = 488 * MiB;
constexpr size_t WS_TOK = 560 * MiB;
constexpr size_t WS_GOFF = 562 * MiB;
constexpr size_t WS_BON = 1008 * MiB;
constexpr size_t WS_NEED = 1012 * MiB;
constexpr int SM_MOD = 0;
constexpr int SM_ROPE = 5 * 12288;
constexpr int SM_MISC = SM_ROPE + 128 * 32;
constexpr int SM_WRT = SM_MISC + 64;
constexpr int SM_WET = SM_WRT + 36 * 2048;
constexpr int CW_BAR = 4096;
constexpr int CW_ATT = 8192;
constexpr int CW_MODPUB = 24576 + 64 * 301;
constexpr int CW_CNT = 16384, CNT_STRIDE = 64;

constexpr int RING_BYTES = 131072, LDS_BYTES = 147456, LDSCTL_OFF = LDS_BYTES - 4096, MISC_OFF = LDSCTL_OFF + 2048;

__device__ __forceinline__ float bf2f(unsigned b) { return __uint_as_float(b << 16); }
typedef __bf16 bf16x2_t __attribute__((ext_vector_type(2)));
__device__ __forceinline__ unsigned cvt_pk_bf16(float lo, float hi) { const f32x2 v = {lo, hi}; const bf16x2_t b = __builtin_convertvector(v, bf16x2_t); return __builtin_bit_cast(unsigned, b); }
__device__ __forceinline__ unsigned pk_f16(float lo, float hi) { _Float16 a = (_Float16)lo, b = (_Float16)hi; return (unsigned)__builtin_bit_cast(unsigned short, a) | ((unsigned)__builtin_bit_cast(unsigned short, b) << 16); }
__device__ __forceinline__ float f16lo(unsigned w) { return (float)__builtin_bit_cast(_Float16, (unsigned short)(w & 0xffffu)); }
__device__ __forceinline__ float f16hi(unsigned w) { return (float)__builtin_bit_cast(_Float16, (unsigned short)(w >> 16)); }
__device__ __forceinline__ float sigmoidf_(float x) { return __builtin_amdgcn_rcpf(1.0f + __expf(-x)); }
__device__ __forceinline__ float wave_sum(float v) {
#pragma unroll
    for (int o = 1; o < 64; o <<= 1) v += __shfl_xor(v, o);
    return v;
}
__device__ __forceinline__ float red16(float v) {
    v += __builtin_bit_cast(float, __builtin_amdgcn_update_dpp(0, __builtin_bit_cast(int, v), 0xB1, 0xF, 0xF, true));
    v += __builtin_bit_cast(float, __builtin_amdgcn_update_dpp(0, __builtin_bit_cast(int, v), 0x4E, 0xF, 0xF, true));
    v += __builtin_bit_cast(float, __builtin_amdgcn_update_dpp(0, __builtin_bit_cast(int, v), 0x141, 0xF, 0xF, true));
    v += __builtin_bit_cast(float, __builtin_amdgcn_update_dpp(0, __builtin_bit_cast(int, v), 0x140, 0xF, 0xF, true));
    return v;
}

namespace pg8 {
#define PG8_LAS __attribute__((address_space(3)))
typedef unsigned short bf16_t;
constexpr int BM = 256, BK = 64, HALF = 128, HTB = HALF * BK * 2, STAGE_BYTES = 8 * HTB;
__host__ __device__ __forceinline__ int lds_byte(int r, int c) { const int st = (r >> 4) * 2 + (c >> 5), rr = r & 15, cc = c & 31, ob = rr * 64 + cc * 2; return st * 1024 + (ob ^ (((ob >> 9) & 1) << 5)); }
__host__ __device__ __forceinline__ void stage_rc(int b, int& R, int& C) { const int st = b / 1024, sb = b % 1024, swz = sb ^ (((sb >> 9) & 1) << 5); R = (st >> 1) * 16 + swz / 64; C = (st & 1) * 32 + (swz % 64) / 2; }
__host__ __device__ __forceinline__ int perm32(int rho) { const int n = rho >> 4, i = rho & 15; return 8 * (i >> 2) + 4 * n + (i & 3); }
struct Unit { int kind, pm, pn; };
__device__ __forceinline__ void tile_order(int L, int nM, int nN, int& pm, int& pn) {
    const int nwg = nM * nN; int wgid = L;
    { const int q = nwg / 8, r = nwg % 8, xcd = wgid % 8, off = wgid / 8; wgid = (xcd < r ? xcd * (q + 1) : r * (q + 1) + (xcd - r) * q) + off; }
    const int nig = 8 * nN, gid = wgid / nig, fm = gid * 8, gsz = (nM - fm) < 8 ? (nM - fm) : 8;
    pm = fm + ((wgid % nig) % gsz); pn = (wgid % nig) / gsz;
}
template <class Epi, class Sched, bool GATHER = false>
__device__ __forceinline__ void gemm_phase(PG8_LAS unsigned char* lds, const int lda, const int ldb, const Sched& S, const Epi& E, const unsigned* gtab = nullptr) {
    const int tid = threadIdx.x, wid = __builtin_amdgcn_readfirstlane(tid >> 6), lane = tid & 63, wr = wid >> 2, wc = wid & 3, fr = lane & 15, fq = lane >> 4;
    unsigned voffA[2], voffA1[2], nvA[2], nvA1[2], voffB[2]; int gR[2], gC[2];
#pragma unroll
    for (int i = 0; i < 2; ++i) { int R, C; stage_rc(tid * 16 + i * 8192, R, C); const int Rb = (R & ~31) + perm32(R & 31); gR[i] = R; gC[i] = C * 2;
        voffA[i] = (unsigned)(R * lda + C) * 2u; voffA1[i] = voffA[i] + (unsigned)(HALF * lda * 2); nvA[i] = voffA[i]; nvA1[i] = voffA1[i]; voffB[i] = (unsigned)(Rb * ldb + C) * 2u; }
    const size_t kstep = (size_t)(BK * 2);
    const size_t hstepB = (size_t)HALF * ldb * 2;
    const unsigned ldsw = (unsigned)wid * 1024u;
    const int aoff = lds_byte(wr * 64 + fr, fq * 8), boff = lds_byte(wc * 32 + fr, fq * 8);
#define PG8_SA(b, h) (((b) * 2 + (h)) * HTB)
#define PG8_SB(b, h) ((4 + (b) * 2 + (h)) * HTB)
#define PG8_STAGE(bufoff, gbase, voff) do { _Pragma("unroll") for (int _i = 0; _i < 2; ++_i) \
        __builtin_amdgcn_global_load_lds((const unsigned*)((const char*)(gbase) + (voff)[_i]), (PG8_LAS unsigned*)(lds + (bufoff) + ldsw + _i * 8192), 16, 0, 0); } while (0)
#define PG8_LDA(dst, b, h) do { _Pragma("unroll") for (int m = 0; m < 4; ++m) _Pragma("unroll") for (int k = 0; k < 2; ++k) dst[m][k] = *(const PG8_LAS bf16x8*)(lds + PG8_SA(b, h) + aoff + m * 2048 + k * 1024); } while (0)
#define PG8_LDB(dst, b, h) do { _Pragma("unroll") for (int n = 0; n < 2; ++n) _Pragma("unroll") for (int k = 0; k < 2; ++k) dst[n][k] = *(const PG8_LAS bf16x8*)(lds + PG8_SB(b, h) + boff + n * 2048 + k * 1024); } while (0)
#define PG8_MMA(ai, bj, At, Bt) do { __builtin_amdgcn_s_setprio(1); _Pragma("unroll") for (int m = 0; m < 4; ++m) _Pragma("unroll") for (int n = 0; n < 2; ++n) _Pragma("unroll") for (int k = 0; k < 2; ++k) \
        acc[ai][bj][m][n] = __builtin_amdgcn_mfma_f32_16x16x32_bf16(Bt[n][k], At[m][k], acc[ai][bj][m][n], 0, 0, 0); __builtin_amdgcn_s_setprio(0); } while (0)
#define PG8_WAIT_V(n) asm volatile("s_waitcnt vmcnt(" #n ")" ::: "memory")
#define PG8_WAIT_L(n) asm volatile("s_waitcnt lgkmcnt(" #n ")" ::: "memory")
#define PG8_BAR __builtin_amdgcn_s_barrier()
#define PG8_SCHED __builtin_amdgcn_sched_barrier(0)
    Unit cur, nxt; int ui = 0;
    if (!S.next(0, cur)) return;
    f32x4 acc[2][2][4][2];
#pragma unroll
    for (int a = 0; a < 2; ++a)
#pragma unroll
        for (int b = 0; b < 2; ++b)
#pragma unroll
            for (int m = 0; m < 4; ++m)
#pragma unroll
                for (int n = 0; n < 2; ++n) acc[a][b][m][n] = (f32x4){0.f, 0.f, 0.f, 0.f};
    bf16x8 At[4][2], B0[2][2], B1[2][2];
    const char* cA = S.a_ptr(cur); const char* cB = S.b_ptr(cur); int nt = S.nt(cur);
    if constexpr (GATHER) {
#pragma unroll
        for (int i = 0; i < 2; ++i) { voffA[i] = S.goff(cur, gR[i]) + (unsigned)gC[i]; voffA1[i] = S.goff(cur, HALF + gR[i]) + (unsigned)gC[i]; } }
    PG8_STAGE(PG8_SB(0, 0), cB, voffB); PG8_STAGE(PG8_SB(0, 1), cB + hstepB, voffB); PG8_STAGE(PG8_SA(0, 0), cA, voffA); PG8_STAGE(PG8_SA(0, 1), cA, voffA1);
    if (wr == 1) PG8_BAR;
    PG8_WAIT_V(2); PG8_BAR;
    PG8_STAGE(PG8_SB(1, 0), cB + kstep, voffB); PG8_STAGE(PG8_SA(1, 0), cA + kstep, voffA); PG8_STAGE(PG8_SB(1, 1), cB + hstepB + kstep, voffB);
    PG8_WAIT_V(6); PG8_BAR;
    for (;;) {
        const bool has_next = S.next(ui + 1, nxt);
        const char* nA = has_next ? S.a_ptr(nxt) : cA; const char* nB = has_next ? S.b_ptr(nxt) : cB;
        if constexpr (GATHER) {
#pragma unroll
            for (int i = 0; i < 2; ++i) { nvA[i] = voffA[i]; nvA1[i] = voffA1[i]; }
            if (has_next) {
#pragma unroll
                for (int i = 0; i < 2; ++i) { nvA[i] = S.goff(nxt, gR[i]) + (unsigned)gC[i]; nvA1[i] = S.goff(nxt, HALF + gR[i]) + (unsigned)gC[i]; } } }
        for (int t = 0; t < nt; t += 2) {
            const bool last = (t == nt - 2);
            const char* a1 = cA + (size_t)(t + 1) * kstep;
            const char* a2 = last ? nA : cA + (size_t)(t + 2) * kstep; const char* b2 = last ? nB : cB + (size_t)(t + 2) * kstep;
            const char* a3 = a2 + kstep; const char* b3 = b2 + kstep;
            unsigned va2[2], va21[2];
#pragma unroll
            for (int i = 0; i < 2; ++i) { va2[i] = (GATHER && last) ? nvA[i] : voffA[i]; va21[i] = (GATHER && last) ? nvA1[i] : voffA1[i]; }
            PG8_LDB(B0, 0, 0); PG8_LDB(B1, 0, 1); PG8_SCHED; PG8_LDA(At, 0, 0); PG8_STAGE(PG8_SA(1, 1), a1, voffA1);
            PG8_WAIT_V(8); PG8_WAIT_L(0); PG8_BAR; PG8_MMA(0, 0, At, B0); PG8_MMA(0, 1, At, B1); PG8_BAR; PG8_SCHED;
            PG8_LDA(At, 0, 1); PG8_STAGE(PG8_SB(0, 0), b2, voffB); PG8_STAGE(PG8_SB(0, 1), b2 + hstepB, voffB); PG8_STAGE(PG8_SA(0, 0), a2, va2);
            PG8_WAIT_V(8); PG8_WAIT_L(0); PG8_BAR; PG8_MMA(1, 0, At, B0); PG8_MMA(1, 1, At, B1); PG8_BAR; PG8_SCHED;
            PG8_LDB(B0, 1, 0); PG8_LDB(B1, 1, 1); PG8_SCHED; PG8_LDA(At, 1, 0); PG8_STAGE(PG8_SA(0, 1), a2, va21);
            PG8_WAIT_V(8); PG8_WAIT_L(0); PG8_BAR; PG8_MMA(0, 0, At, B0); PG8_MMA(0, 1, At, B1); PG8_BAR; PG8_SCHED;
            PG8_LDA(At, 1, 1); PG8_STAGE(PG8_SB(1, 0), b3, voffB); PG8_STAGE(PG8_SB(1, 1), b3 + hstepB, voffB); PG8_STAGE(PG8_SA(1, 0), a3, va2);
            PG8_WAIT_V(8); PG8_WAIT_L(0); PG8_BAR; PG8_MMA(1, 0, At, B0); PG8_MMA(1, 1, At, B1); PG8_BAR; PG8_SCHED;
        }
        if (wr == 0) PG8_BAR;
        E(acc, cur, wr, wc, fr, fq);
        if (!has_next) break;
        if (!S.keep(cur)) {
#pragma unroll
        for (int a = 0; a < 2; ++a)
#pragma unroll
            for (int b = 0; b < 2; ++b)
#pragma unroll
                for (int m = 0; m < 4; ++m)
#pragma unroll
                    for (int n = 0; n < 2; ++n) acc[a][b][m][n] = (f32x4){0.f, 0.f, 0.f, 0.f};
        }
        cur = nxt; cA = nA; cB = nB; nt = S.nt(cur); ++ui;
        if (GATHER) {
#pragma unroll
            for (int i = 0; i < 2; ++i) { voffA[i] = nvA[i]; voffA1[i] = nvA1[i]; } }
        if (wr == 1) PG8_BAR;
    }
    PG8_WAIT_V(0);
    PG8_BAR;
#undef PG8_SA
#undef PG8_SB
#undef PG8_STAGE
#undef PG8_LDA
#undef PG8_LDB
#undef PG8_MMA
#undef PG8_WAIT_V
#undef PG8_WAIT_L
#undef PG8_BAR
#undef PG8_SCHED
}
}
using pg8::Unit;

#define XB_TMO      128
#define XB_XCNT(j)  (256  + 64 * (j))
#define XB_XSUB(j)  (1280 + 64 * (j))
#define XB_XGEN(j)  (2304 + 64 * (j))
#define XB_TOP      3328
#define XB_TOPGEN   3392
#define XCD_BAR_WORDS 3456
#define XB_SPIN_CAP (1u << 22)
__device__ __forceinline__ unsigned xb_ld(unsigned* p)              { return __hip_atomic_load(p, __ATOMIC_RELAXED, __HIP_MEMORY_SCOPE_AGENT); }
__device__ __forceinline__ unsigned xb_add(unsigned* p, unsigned v) { return __hip_atomic_fetch_add(p, v, __ATOMIC_RELAXED, __HIP_MEMORY_SCOPE_AGENT); }
__device__ __forceinline__ unsigned xb_xcc_id() { return (unsigned)__builtin_amdgcn_s_getreg((3 << 11) | 20) & 0xFu; }
#define XB_SPIN(cond, bar) do { unsigned _sp = 0; while (cond) { __builtin_amdgcn_s_sleep(1); \
    if ((++_sp & 255u) == 0u) { if (xb_ld(&(bar)[XB_TMO])) break; if (_sp > XB_SPIN_CAP) { atomicAdd(&(bar)[XB_TMO], 1u); break; } } } } while (0)
struct XcdBarrier { unsigned* bar; unsigned x; volatile LAS unsigned* st; };
__device__ __forceinline__ XcdBarrier xcd_barrier_post(unsigned* bar, volatile LAS unsigned* st) {
    XcdBarrier b; b.bar = bar; b.x = xb_xcc_id(); b.st = st;
    if (threadIdx.x == 0) (void)xb_add(&bar[XB_XCNT(b.x)], 1u);
    return b;
}
__device__ __forceinline__ void xcd_barrier_complete(unsigned* bar, unsigned x, unsigned& nloc, unsigned& nx) {
    const unsigned G = gridDim.x * gridDim.y * gridDim.z;
    unsigned sum, cnt, mine, sp = 0u;
    for (;;) {
        sum = 0u; cnt = 0u; mine = 0u;
#pragma unroll
        for (unsigned j = 0; j < 16; ++j) { const unsigned c = xb_ld(&bar[XB_XCNT(j)]); sum += c; cnt += (c > 0u) ? 1u : 0u; mine = (j == x) ? c : mine; }
        if (sum == G) break;
        __builtin_amdgcn_s_sleep(1);
        if ((++sp & 255u) == 0u) { if (xb_ld(&bar[XB_TMO])) break; if (sp > XB_SPIN_CAP) { atomicAdd(&bar[XB_TMO], 1u); break; } }
    }
    nloc = mine > 0u ? mine : 1u; nx = cnt > 0u ? cnt : 1u;
}
__device__ __forceinline__ void xcd_barrier(const XcdBarrier& b) {
    asm volatile("s_waitcnt vmcnt(0)" ::: "memory");
    __syncthreads();
    if (threadIdx.x == 0) {
        unsigned* bar = b.bar;
        __builtin_amdgcn_s_waitcnt(0);
        unsigned nloc = b.st[0], nx = b.st[1];
        if (nloc == 0u) { xcd_barrier_complete(bar, b.x, nloc, nx); b.st[0] = nloc; b.st[1] = nx; }
        const unsigned old = xb_add(&bar[XB_XSUB(b.x)], 1u);
        const unsigned gen = old / nloc;
        if (old + 1u == (gen + 1u) * nloc) {
            __builtin_amdgcn_fence(__ATOMIC_RELEASE, "agent");
            asm volatile("s_waitcnt vmcnt(0)" ::: "memory");
            (void)xb_add(&bar[XB_TOP], 1u);
        }
        XB_SPIN(xb_ld(&bar[XB_TOP]) < (gen + 1u) * nx, bar);
        __builtin_amdgcn_fence(__ATOMIC_ACQUIRE, "agent");
        asm volatile("s_waitcnt vmcnt(0)" ::: "memory");
    }
    __syncthreads();
}

struct Args { const float* in[34]; float* out; unsigned char* ws; int ph_lo, ph_hi; };
struct Frame {
    LAS unsigned char* lds;
    unsigned char* ws;
    int tid, lane, wave, G, bid;
    int gw, ngw;
};

__device__ __forceinline__ void tr_item(const float* W, int Nsrc, int n0s, int k0, int kvalid, bf16* WT, int ldk, int drow, LAS float* scr, int lane) {
#pragma unroll 8
    for (int i = 0; i < 32; ++i) { const int kk = 2 * i + (lane >> 5); const int k = k0 + kk;
        scr[kk * 33 + (lane & 31)] = (k < kvalid) ? W[(size_t)k * Nsrc + n0s + (lane & 31)] : 0.f; }
    LDS_WAIT(); asm volatile("" ::: "memory");
    const int c = lane & 7;
#pragma unroll
    for (int j = 0; j < 4; ++j) { const int n = (lane >> 3) + 8 * j; const LAS float* s = scr + (8 * c) * 33 + n;
        v4u o; o.x = cvt_pk_bf16(s[0 * 33], s[1 * 33]); o.y = cvt_pk_bf16(s[2 * 33], s[3 * 33]); o.z = cvt_pk_bf16(s[4 * 33], s[5 * 33]); o.w = cvt_pk_bf16(s[6 * 33], s[7 * 33]);
        *(GAS v4u*)(WT + (size_t)(drow + n) * ldk + k0 + 8 * c) = o; }
    LDS_WAIT(); asm volatile("" ::: "memory");
}
__device__ __forceinline__ void tr_job(int r, const float* W, int Nsrc, int c0, int ncols, int K, bf16* WT, int ldk, int drow0, LAS float* scr, int lane) {
    const int nblk = ncols / 32, kb = r / nblk, nb = r % nblk;
    tr_item(W, Nsrc, c0 + 32 * nb, 64 * kb, K, WT, ldk, drow0 + 32 * nb, scr, lane);
}

__device__ __forceinline__ void tr_item64(const float* W, int Nsrc, int n0s, int k0, bf16* WT, int ldk, int drow, LAS float* scr, int lane) {
    f32x4 v[16];
    const float* src = W + (size_t)(k0 + (lane >> 4)) * Nsrc + n0s + 4 * (lane & 15);
#pragma unroll
    for (int it = 0; it < 16; ++it) v[it] = *(const GAS f32x4*)(src + (size_t)(4 * it) * Nsrc);
    LAS float* wp = scr + (4 * (lane & 15)) * 65 + (lane >> 4);
#pragma unroll
    for (int it = 0; it < 16; ++it) { wp[4 * it] = v[it].x; wp[65 + 4 * it] = v[it].y; wp[130 + 4 * it] = v[it].z; wp[195 + 4 * it] = v[it].w; }
    LDS_WAIT(); asm volatile("" ::: "memory");
    const int c = lane & 7;
#pragma unroll
    for (int j = 0; j < 8; ++j) { const int n = (lane >> 3) + 8 * j; const LAS float* sp = scr + n * 65 + 8 * c;
        v4u o; o.x = cvt_pk_bf16(sp[0], sp[1]); o.y = cvt_pk_bf16(sp[2], sp[3]); o.z = cvt_pk_bf16(sp[4], sp[5]); o.w = cvt_pk_bf16(sp[6], sp[7]);
        *(GAS v4u*)(WT + (size_t)(drow + n) * ldk + k0 + 8 * c) = o; }
    LDS_WAIT(); asm volatile("" ::: "memory");
}
__device__ __forceinline__ void tr_job64(int r, const float* W, int Nsrc, int c0, int ncols, bf16* WT, int ldk, int drow0, LAS float* scr, int lane) {
    const int nblk = ncols / 64, kb = r / nblk, nb = r % nblk;
    tr_item64(W, Nsrc, c0 + 64 * nb, 64 * kb, WT, ldk, drow0 + 64 * nb, scr, lane);
}

__device__ __forceinline__ void phase_prologue(const Frame& F, const Args& A) {
    float* sm = (float*)(F.ws + WS_SMALL);
    {
        LAS float* sl = (LAS float*)F.lds;
        for (int i = F.tid; i < 5 * 2048; i += 512) { const int r = i >> 11, k = i & 2047; const float v = (r < 4) ? A.in[1][r * 2048 + k] : A.in[3][k]; sl[i] = v * sigmoidf_(v); }
        __syncthreads();
        for (int it = F.gw; it < 192 * 16; it += F.ngw) {
            const int cgp = it >> 4, kc = it & 15, n = cgp * 64 + F.lane, k0 = kc * 128;
            const float* W = A.in[4] + (size_t)k0 * 12288 + n;
            float a0 = 0.f, a1 = 0.f, a2 = 0.f, a3 = 0.f, a4 = 0.f;
#pragma unroll 16
            for (int k = 0; k < 128; ++k) { const float w = W[(size_t)k * 12288]; const int kk = k0 + k;
                a0 += sl[kk] * w; a1 += sl[2048 + kk] * w; a2 += sl[4096 + kk] * w; a3 += sl[6144 + kk] * w; a4 += sl[8192 + kk] * w; }
            const float bb = kc == 0 ? A.in[5][n] : 0.f;
            atomicAdd(sm + SM_MOD + n, a0 + bb); atomicAdd(sm + SM_MOD + 12288 + n, a1 + bb); atomicAdd(sm + SM_MOD + 2 * 12288 + n, a2 + bb);
            atomicAdd(sm + SM_MOD + 3 * 12288 + n, a3 + bb); atomicAdd(sm + SM_MOD + 4 * 12288 + n, a4 + bb);
        }
        asm volatile("s_waitcnt vmcnt(0)" ::: "memory");
        __syncthreads();
        if (F.tid == 0) { __builtin_amdgcn_fence(__ATOMIC_RELEASE, "agent"); asm volatile("s_waitcnt vmcnt(0)" ::: "memory");
            __hip_atomic_fetch_add((unsigned*)(F.ws + WS_CTL) + CW_MODPUB, 1u, __ATOMIC_RELAXED, __HIP_MEMORY_SCOPE_AGENT); }
    }
    if (F.bid == 24) {
        for (int i = F.tid; i < 128 * 16; i += 512) { const int pos = i >> 4, fi = i & 15;
            const float invf = powf(10000.0f, -(float)fi / 16.0f); const float angf = (float)pos * invf;
            double a = (double)angf; const double twopi = 6.283185307179586476925; a -= twopi * rint(a / twopi);
            const double a2 = a * a; double s = 0.0, c = 0.0;
            { double term = a; s = a; for (int n = 1; n <= 12; ++n) { term *= -a2 / (double)((2 * n) * (2 * n + 1)); s += term; } }
            { double term = 1.0; c = 1.0; for (int n = 1; n <= 12; ++n) { term *= -a2 / (double)((2 * n - 1) * (2 * n)); c += term; } }
            sm[SM_ROPE + 2 * i] = (float)c; sm[SM_ROPE + 2 * i + 1] = (float)s; }
        if (F.wave == 0) {
            const float* lv = A.in[22];
            const float v0 = lv[F.lane] * lv[64 + F.lane], v1 = lv[128 + F.lane] * lv[192 + F.lane];
            const float s0 = wave_sum(v0), s1 = wave_sum(v1);
            float gq = fabsf(A.in[20][F.lane]), gk = fabsf(A.in[21][F.lane]);
#pragma unroll
            for (int o = 1; o < 64; o <<= 1) { gq = fmaxf(gq, __shfl_xor(gq, o)); gk = fmaxf(gk, __shfl_xor(gk, o)); }
            if (F.lane == 0) { sm[SM_MISC + 0] = expf(s0) - expf(s1) + 0.2f; sm[SM_MISC + 1] = C2 * 64.0f * gq * gk * 1.02f + 0.25f; }
        }
    }
    if (F.bid >= 25 && F.bid < 29) {
        for (int i = (F.bid - 25) * 512 + F.tid; i < 36 * 2048; i += 4 * 512) { const int n = i >> 11, k = i & 2047;
            sm[SM_WRT + i] = (n < 4) ? A.in[27][k * 4 + n] : A.in[29][k * 32 + (n - 4)];
            if (n >= 4) ((_Float16*)(sm + SM_WET))[(n - 4) * 2048 + k] = (_Float16)A.in[29][k * 32 + (n - 4)]; }
    }
    __syncthreads();
    LAS float* scr = (LAS float*)(F.lds + F.wave * 16640);
    bf16* W1T = (bf16*)(F.ws + WS_W1T); bf16* WVT = (bf16*)(F.ws + WS_WVT); bf16* LW = (bf16*)(F.ws + WS_LW);
    constexpr int J1 = 32 * 58, J2 = 32 * 32, J3 = 32 * 16, I4 = 2 * 32, I5 = 4 * 32, I6 = 128;
    constexpr int NIT = J1 + J2 + J3 + 4 * I4 + I5 + I6;
    for (int it = F.gw; it < NIT; it += F.ngw) {
        int r = it;
        if (r < J1) { tr_job64(r, A.in[8], NIN, 0, 3712, W1T, 2048, 0, scr, F.lane); continue; } r -= J1;
        if (r < J2) { tr_job64(r, A.in[8], NIN, 3712, 2048, W1T, 2048, 3840, scr, F.lane); continue; } r -= J2;
        if (r < J3) { tr_job64(r, A.in[8], NIN, 5760, 1024, WVT, 2048, 0, scr, F.lane); continue; } r -= J3;
        if (r < I4) { tr_job(r, A.in[11], 1024, 0, 1024, 96, LW, 256, 0, scr, F.lane); continue; } r -= I4;
        if (r < I4) { tr_job(r, A.in[11] + 96 * 1024, 1024, 0, 1024, 96, LW + 1024 * 256, 256, 0, scr, F.lane); continue; } r -= I4;
        if (r < I4) { tr_job(r, A.in[13], 1024, 0, 1024, 96, LW + 2 * 1024 * 256, 256, 0, scr, F.lane); continue; } r -= I4;
        if (r < I4) { tr_job(r, A.in[13] + 96 * 1024, 1024, 0, 1024, 96, LW + 3 * 1024 * 256, 256, 0, scr, F.lane); continue; } r -= I4;
        if (r < I5) { tr_job(r, A.in[14], 1024, 0, 1024, 256, LW + 4 * 1024 * 256, 256, 0, scr, F.lane); continue; } r -= I5;
        { GAS v4u* z = (GAS v4u*)(W1T + (size_t)(3712 + r) * 2048) + F.lane; const v4u zz = {0u, 0u, 0u, 0u};
#pragma unroll
          for (int j = 0; j < 4; ++j) z[64 * j] = zz; }
    }
}

template <bool EXT>
__device__ __forceinline__ void phase_hx(const Frame& F, const Args& A, bf16* dst) {
    const float* sm = (const float*)(F.ws + WS_SMALL);
    const int nrows = EXT ? ME : ML;
    auto rowsrc = [&](int e) -> const GAS f32x4* {
        const float* src;
        if (EXT) { const int b = e / TE, j = e - b * TE; src = (j < CTXL) ? A.in[2] + (size_t)(b * CTXL + j) * D : A.in[0] + (size_t)(b * T + j - CTXL) * D; }
        else src = A.in[0] + (size_t)e * D;
        return (const GAS f32x4*)src + F.lane; };
    int e = F.gw;
    f32x4 v[8];
    if (e < nrows) { const GAS f32x4* xr = rowsrc(e);
#pragma unroll
        for (int q = 0; q < 8; ++q) v[q] = xr[64 * q]; }
    for (; e < nrows; e += F.ngw) {
        const int en = e + F.ngw;
        f32x4 vn[8];
        { const GAS f32x4* xr = rowsrc(en < nrows ? en : e);
#pragma unroll
          for (int q = 0; q < 8; ++q) vn[q] = xr[64 * q]; }
        const float* mod;
        if (EXT) { const int b = e / TE, j = e - b * TE; mod = sm + SM_MOD + ((j < CTXL) ? 4 : b) * 12288; }
        else mod = sm + SM_MOD + (e / T) * 12288;
        float s = 0.f;
#pragma unroll
        for (int q = 0; q < 8; ++q) s += (v[q].x * v[q].x + v[q].y * v[q].y) + (v[q].z * v[q].z + v[q].w * v[q].w);
        const float rstd = rsqrtf(wave_sum(s) * (1.0f / D) + 1e-6f);
        GAS v2u* o8 = (GAS v2u*)(dst + (size_t)e * D) + F.lane;
#pragma unroll
        for (int q = 0; q < 8; ++q) { const int c = 4 * F.lane + 256 * q;
            const f32x4 g = *(const f32x4*)(A.in[6] + c), sh = *(const f32x4*)(mod + c), sc = *(const f32x4*)(mod + 2048 + c);
            const f32x4 y = v[q] * rstd * g * (sc + 1.0f) + sh;
            v2u w; w.x = cvt_pk_bf16(y.x, y.y); w.y = cvt_pk_bf16(y.z, y.w); o8[64 * q] = w; }
#pragma unroll
        for (int q = 0; q < 8; ++q) v[q] = vn[q];
    }
}

struct SchedInproj {
    const char* hx; const char* w1t; const char* wvt; int G, c;
    static constexpr int N0 = 132 * 23, N1 = 4 * 132;
    __device__ __forceinline__ bool next(int i, Unit& u) const { const int L = i * G + c; if (L >= N0 + N1) return false;
        if (L < N0) { u.kind = 0; pg8::tile_order(L, 132, 23, u.pm, u.pn); } else { u.kind = 1; const int r = L - N0; u.pm = r & 3; u.pn = r >> 2; } return true; }
    __device__ __forceinline__ const char* a_ptr(const Unit& u) const { return (u.kind == 0 ? hx : wvt) + (size_t)u.pm * 256 * 2048 * 2; }
    __device__ __forceinline__ const char* b_ptr(const Unit& u) const { return (u.kind == 0 ? w1t : hx) + (size_t)u.pn * 256 * 2048 * 2; }
    __device__ __forceinline__ int nt(const Unit&) const { return 32; }
    __device__ __forceinline__ bool keep(const Unit&) const { return false; }
};
struct EpiInproj {
    bf16* P1; bf16* Vt;
    __device__ __forceinline__ void operator()(const f32x4 (&acc)[2][2][4][2], const Unit& u, int wr, int wc, int fr, int fq) const {
        bf16* base; size_t ldc;
        if (u.kind == 0) { base = P1 + (size_t)(u.pm * 256) * P1LD + u.pn * 256; ldc = P1LD; }
        else { const int b = u.pn / 33, jt = u.pn - b * 33; base = Vt + ((size_t)b * 1024 + u.pm * 256) * TE + jt * 256; ldc = TE; }
        const int row0 = wr * 64 + fr, col0 = wc * 32 + 8 * fq;
#pragma unroll
        for (int ai = 0; ai < 2; ++ai)
#pragma unroll
            for (int m = 0; m < 4; ++m) { bf16* rowp = base + (size_t)(row0 + ai * 128 + m * 16) * ldc + col0;
#pragma unroll
                for (int bj = 0; bj < 2; ++bj) { const f32x4 v0 = acc[ai][bj][m][0], v1 = acc[ai][bj][m][1];
                    v4u w; w.x = cvt_pk_bf16(v0[0], v0[1]); w.y = cvt_pk_bf16(v0[2], v0[3]); w.z = cvt_pk_bf16(v1[0], v1[1]); w.w = cvt_pk_bf16(v1[2], v1[3]);
                    *(v4u*)(rowp + bj * 128) = w; } }
    }
};

__device__ __forceinline__ void phase_e1(const Frame& F, const Args& A, const int pr = 0) {
    const float* sm = (const float*)(F.ws + WS_SMALL);
    bf16* P1 = (bf16*)(F.ws + WS_P1); bf16* XL = (bf16*)(F.ws + (pr ? 800 * MiB : WS_XL));
    bf16* QKD = pr ? (bf16*)(F.ws + 646 * MiB) : P1 + PQ; const int qkld = pr ? 2048 : P1LD;
    const int lane = F.lane, gidx = lane >> 1, half = lane & 1;
    const bool isq = gidx < 16;
    const int qkcol = (isq ? PQ + gidx * 64 : PK + (gidx - 16) * 64) + 32 * half;
    float gain[32];
#pragma unroll
    for (int i = 0; i < 32; ++i) gain[i] = (isq ? A.in[20] : A.in[21])[32 * half + i];
    for (int e = F.gw; e < ME; e += F.ngw) {
        const int b = e / TE, j = e - b * TE; const bool lat = j >= CTXL; const int t = j - CTXL;
        bf16* row = P1 + (size_t)e * P1LD;
        if (lat || !isq) {
            v4u raw[4];
#pragma unroll
            for (int q = 0; q < 4; ++q) raw[q] = *(const GAS v4u*)(row + qkcol + 8 * q);
            float v[32]; float ss = 0.f;
#pragma unroll
            for (int q = 0; q < 4; ++q)
#pragma unroll
                for (int w = 0; w < 4; ++w) { const unsigned x = raw[q][w]; v[8 * q + 2 * w] = bf2f(x & 0xffffu); v[8 * q + 2 * w + 1] = bf2f(x >> 16); }
#pragma unroll
            for (int i = 0; i < 32; ++i) ss += v[i] * v[i];
            ss += __shfl_xor(ss, 1);
            const float rstd = rsqrtf(ss * (1.0f / 64.0f) + 1e-6f);
#pragma unroll
            for (int i = 0; i < 32; ++i) v[i] = v[i] * rstd * gain[i];
            if (lat) {
                const int pos = half == 0 ? (t >> 6) : (t & 63);
                const f32x2* cs = (const f32x2*)(sm + SM_ROPE) + pos * 16;
#pragma unroll
                for (int i = 0; i < 16; ++i) { const f32x2 c = cs[i]; const float x1 = v[i], x2 = v[i + 16]; v[i] = x1 * c.x - x2 * c.y; v[i + 16] = x2 * c.x + x1 * c.y; }
            }
            if (isq) {
#pragma unroll
                for (int i = 0; i < 32; ++i) v[i] *= C2;
            }
#pragma unroll
            for (int q = 0; q < 4; ++q) { v4u w; w.x = cvt_pk_bf16(v[8 * q], v[8 * q + 1]); w.y = cvt_pk_bf16(v[8 * q + 2], v[8 * q + 3]); w.z = cvt_pk_bf16(v[8 * q + 4], v[8 * q + 5]); w.w = cvt_pk_bf16(v[8 * q + 6], v[8 * q + 7]);
                *(GAS v4u*)(QKD + (size_t)e * qkld + (qkcol - PQ) + 8 * q) = w; }
        }
        const bool hp = (j != 0) && (j != CTXL), hn = (j != CTXL - 1) && (j != TE - 1);
        bf16* xl = XL + (size_t)e * XLLD;
#pragma unroll
        for (int rnd = 0; rnd < 2; ++rnd) {
            const int og = lane + 64 * rnd;
            if (og < 96) {
                const int blk = og >> 4, gi = og & 15;
                v4u w = {0u, 0u, 0u, 0u};
                if (og >= 64 || gi < 12) {
                    const int c = og < 64 ? blk * 96 + gi * 8 : 384 + (og - 64) * 8, col = 3072 + c;
                    const v4u p0 = *(const GAS v4u*)(row + col);
                    v4u pp = {0u, 0u, 0u, 0u}, pn = {0u, 0u, 0u, 0u};
                    if (hp) pp = *(const GAS v4u*)(row + col - P1LD);
                    if (hn) pn = *(const GAS v4u*)(row + col + P1LD);
                    const f32x4 mu0 = *(const f32x4*)(A.in[9] + col), mu1 = *(const f32x4*)(A.in[9] + col + 4);
                    float o[8];
#pragma unroll
                    for (int q = 0; q < 4; ++q)
#pragma unroll
                        for (int hh = 0; hh < 2; ++hh) { const int sh = 16 * hh; const int idx = 2 * q + hh;
                            const float p = bf2f((p0[q] >> sh) & 0xffffu), a = bf2f((pp[q] >> sh) & 0xffffu), n = bf2f((pn[q] >> sh) & 0xffffu);
                            const float mu = idx < 4 ? mu0[idx & 3] : mu1[idx & 3];
                            const float sv = p + mu * (0.5f * (a + n) - p);
                            float r;
                            if (og >= 64) r = sigmoidf_(sv);
                            else if (blk < 2) { const float sc = fminf(fmaxf(sv, -15.f), 15.f); const float t2 = __expf(2.0f * sc); r = (t2 - 1.0f) * __builtin_amdgcn_rcpf(t2 + 1.0f); }
                            else r = sv;
                            o[idx] = r; }
                    w.x = cvt_pk_bf16(o[0], o[1]); w.y = cvt_pk_bf16(o[2], o[3]); w.z = cvt_pk_bf16(o[4], o[5]); w.w = cvt_pk_bf16(o[6], o[7]);
                }
                *(GAS v4u*)(xl + og * 8) = w;
            }
        }
    }
}

struct SchedLora {
    const char* xl; const char* lw; int G, c;
    __device__ __forceinline__ bool next(int i, Unit& u) const { const int L = i * G + c; if (L >= 5 * 528) return false; u.kind = L / 528; const int r = L - u.kind * 528; u.pm = r >> 2; u.pn = r & 3; return true; }
    __device__ __forceinline__ const char* a_ptr(const Unit& u) const { return xl + ((size_t)u.pm * 256 * XLLD + u.kind * 128) * 2; }
    __device__ __forceinline__ const char* b_ptr(const Unit& u) const { return lw + ((size_t)u.kind * 1024 + u.pn * 256) * 256 * 2; }
    __device__ __forceinline__ int nt(const Unit& u) const { return u.kind == 4 ? 4 : 2; }
    __device__ __forceinline__ bool keep(const Unit&) const { return false; }
};
struct EpiLora {
    unsigned short* LO; bf16* G; const float* w0; const float* a0;
    __device__ __forceinline__ void operator()(const f32x4 (&acc)[2][2][4][2], const Unit& u, int wr, int wc, int fr, int fq) const {
        const int row0 = u.pm * 256 + wr * 64 + fr, col0 = u.pn * 256 + wc * 32 + 8 * fq;
        const int kind = u.kind;
        unsigned short* base = (kind < 4) ? LO + (size_t)kind * ME * 1024 : G;
        const float* bias = (kind < 2) ? w0 + kind * 1024 : a0 + (kind & 1) * 1024;
#pragma unroll
        for (int bj = 0; bj < 2; ++bj) {
            f32x4 b0 = {0.f, 0.f, 0.f, 0.f}, b1 = {0.f, 0.f, 0.f, 0.f};
            if (kind < 4) { b0 = *(const f32x4*)(bias + col0 + bj * 128); b1 = *(const f32x4*)(bias + col0 + bj * 128 + 4); }
#pragma unroll
            for (int ai = 0; ai < 2; ++ai)
#pragma unroll
                for (int m = 0; m < 4; ++m) { f32x4 v0 = acc[ai][bj][m][0] + b0, v1 = acc[ai][bj][m][1] + b1; v4u w;
                    if (kind == 2 || kind == 3) {
                        v2u w8; unsigned q8[8];
#pragma unroll
                        for (int q = 0; q < 4; ++q) { q8[q] = (unsigned)(sigmoidf_(v0[q]) * 255.0f + 0.5f); q8[4 + q] = (unsigned)(sigmoidf_(v1[q]) * 255.0f + 0.5f); }
                        w8.x = q8[0] | (q8[1] << 8) | (q8[2] << 16) | (q8[3] << 24); w8.y = q8[4] | (q8[5] << 8) | (q8[6] << 16) | (q8[7] << 24);
                        *(v2u*)((unsigned char*)(LO + (size_t)2 * ME * 1024) + ((size_t)(kind - 2) * ME + (row0 + ai * 128 + m * 16)) * 1024 + col0 + bj * 128) = w8;
                        continue; }
                    if (kind < 4) { const float sc = 0.6065306597126334f;
#pragma unroll
                        for (int q = 0; q < 4; ++q) { v0[q] = sc * sigmoidf_(v0[q]); v1[q] = sc * sigmoidf_(v1[q]); }
                        w.x = pk_f16(v0[0], v0[1]); w.y = pk_f16(v0[2], v0[3]); w.z = pk_f16(v1[0], v1[1]); w.w = pk_f16(v1[2], v1[3]); }
                    else { w.x = cvt_pk_bf16(v0[0], v0[1]); w.y = cvt_pk_bf16(v0[2], v0[3]); w.z = cvt_pk_bf16(v1[0], v1[1]); w.w = cvt_pk_bf16(v1[2], v1[3]); }
                    *(v4u*)(base + (size_t)(row0 + ai * 128 + m * 16) * 1024 + col0 + bj * 128) = w; }
        }
    }
};

__device__ __forceinline__ int sc_tok(int dir, int sidx) { return dir == 0 ? sidx : (sidx < CTXL ? CTXL - 1 - sidx : TE + CTXL - 1 - sidx); }
constexpr int S2_NCH = TE / 32, S2_NS = 5, S2_SLOT = 24576, S2_ZY = 12288, S2_PAR = S2_NS * S2_SLOT;
typedef f32x16 C16;
struct Fr2 { bf16x8 k[2]; };
#define S2_DPP(v, ctrl, rm) __builtin_bit_cast(float, __builtin_amdgcn_update_dpp(0, __builtin_bit_cast(int, (v)), (ctrl), (rm), 0xF, false))
__device__ __forceinline__ float s2_prefix32(float v) {
    v += S2_DPP(v, 0x111, 0xF); v += S2_DPP(v, 0x112, 0xF); v += S2_DPP(v, 0x114, 0xF); v += S2_DPP(v, 0x118, 0xF); v += S2_DPP(v, 0x142, 0xA);
    return v;
}
__device__ __forceinline__ bf16x8 s2_pk8(const float* x) { v4u a; a.x = cvt_pk_bf16(x[0], x[1]); a.y = cvt_pk_bf16(x[2], x[3]); a.z = cvt_pk_bf16(x[4], x[5]); a.w = cvt_pk_bf16(x[6], x[7]); return __builtin_bit_cast(bf16x8, a); }
__device__ __forceinline__ Fr2 s2_pack(const C16& x, const float sg = 1.0f) {
    Fr2 f; v4u a, b;
    a.x = cvt_pk_bf16(sg * x[0], sg * x[1]); a.y = cvt_pk_bf16(sg * x[2], sg * x[3]); a.z = cvt_pk_bf16(sg * x[4], sg * x[5]); a.w = cvt_pk_bf16(sg * x[6], sg * x[7]);
    b.x = cvt_pk_bf16(sg * x[8], sg * x[9]); b.y = cvt_pk_bf16(sg * x[10], sg * x[11]); b.z = cvt_pk_bf16(sg * x[12], sg * x[13]); b.w = cvt_pk_bf16(sg * x[14], sg * x[15]);
    f.k[0] = __builtin_bit_cast(bf16x8, a); f.k[1] = __builtin_bit_cast(bf16x8, b); return f;
}
#define S2_MF(A_, B_, C_) __builtin_amdgcn_mfma_f32_32x32x16_bf16((A_), (B_), (C_), 0, 0, 0)
__device__ __forceinline__ C16 s2_mm2(const Fr2& A, const Fr2& B, C16 acc) { acc = S2_MF(A.k[0], B.k[0], acc); acc = S2_MF(A.k[1], B.k[1], acc); return acc; }
__device__ __forceinline__ C16 s2_mm4(const bf16x8* A, const bf16x8* B) {
    C16 acc;
#pragma unroll
    for (int r = 0; r < 16; ++r) acc[r] = 0.f;
#pragma unroll
    for (int s = 0; s < 4; ++s) acc = S2_MF(A[s], B[s], acc);
    return acc;
}
__device__ __forceinline__ C16 s2_zero() { C16 z;
#pragma unroll
    for (int r = 0; r < 16; ++r) z[r] = 0.f;
    return z; }
#define S2_ROW(r, hi) (8 * ((r) >> 2) + 4 * (hi) + ((r) & 3))
__device__ __forceinline__ unsigned s2_poll(volatile LAS unsigned* p) { return *p; }

__device__ __forceinline__ void phase_scan(const Frame& F, const Args& A) {
    const bf16* P1 = (const bf16*)(F.ws + WS_P1);
    const unsigned short* LO = (const unsigned short*)(F.ws + WS_LO);
    LAS unsigned char* lds = F.lds;
    const int lane = F.lane, wave = F.wave, n32 = lane & 31, hi = lane >> 5;
    volatile LAS unsigned* flg = (volatile LAS unsigned*)(lds + LDSCTL_OFF);
    LAS float* par = (LAS float*)(lds + S2_PAR);
    for (int item = F.bid; item < 128; item += F.G) {
        const int dir = item & 1, h = (item >> 1) & 15, b = item >> 5;
        bf16* Yd = dir ? (bf16*)(F.ws + WS_YB) : (bf16*)((unsigned char*)A.out + OUT_YF);
        __syncthreads();
        if (F.tid < 32) flg[F.tid] = 0u;
        if (F.tid < 384) { const int q = F.tid >> 6, cc = h * 64 + (F.tid & 63);
            par[F.tid] = q == 0 ? A.in[9][cc] : (q == 1 ? A.in[9][1024 + cc] : (q == 2 ? A.in[9][2048 + cc] : (q == 3 ? A.in[15][cc] : (q == 4 ? A.in[16][cc] : A.in[17][cc])))); }
        __syncthreads();
        if (wave == 0) {
            C16 St[2][2];
#pragma unroll
            for (int a = 0; a < 2; ++a) { St[a][0] = s2_zero(); St[a][1] = s2_zero(); }
            Fr2 IdT;
#pragma unroll
            for (int s1 = 0; s1 < 2; ++s1) { float t8[8];
#pragma unroll
                for (int i = 0; i < 8; ++i) t8[i] = (S2_ROW(8 * s1 + i, hi) == n32) ? 1.0f : 0.0f;
                IdT.k[s1] = s2_pk8(t8); }
            for (int c = 0; c < S2_NCH; ++c) {
                const int slot = c % S2_NS; const LAS unsigned char* sb = lds + slot * S2_SLOT;
                { unsigned sp = 0; while (s2_poll(flg + slot) < (unsigned)(c + 1)) { __builtin_amdgcn_s_sleep(1); if (++sp > (1u << 24)) break; } }
                asm volatile("" ::: "memory");
                Fr2 bS[2][2];
#pragma unroll
                for (int a = 0; a < 2; ++a) { bS[a][0] = s2_pack(St[a][0]); bS[a][1] = s2_pack(St[a][1]); }
                C16 acc[2][3];
#pragma unroll
                for (int a = 0; a < 2; ++a)
#pragma unroll
                    for (int mz = 0; mz < 3; ++mz) {
                        const v4u q0 = *(const LAS v4u*)(sb + S2_ZY + (((mz * 2 + a) * 2 + 0) * 64 + lane) * 16), q1 = *(const LAS v4u*)(sb + S2_ZY + (((mz * 2 + a) * 2 + 1) * 64 + lane) * 16);
#pragma unroll
                        for (int d = 0; d < 4; ++d) { acc[a][mz][2 * d] = bf2f(q0[d] & 0xffffu); acc[a][mz][2 * d + 1] = bf2f(q0[d] >> 16); acc[a][mz][8 + 2 * d] = bf2f(q1[d] & 0xffffu); acc[a][mz][8 + 2 * d + 1] = bf2f(q1[d] >> 16); }
                    }
#pragma unroll
                for (int nb = 0; nb < 3; ++nb)
#pragma unroll
                    for (int s = 0; s < 4; ++s) { const bf16x8 af = *(const LAS bf16x8*)(sb + ((nb * 4 + s) * 64 + lane) * 16);
                        acc[0][nb] = S2_MF(af, bS[0][s >> 1].k[s & 1], acc[0][nb]); acc[1][nb] = S2_MF(af, bS[1][s >> 1].k[s & 1], acc[1][nb]); }
                asm volatile("s_waitcnt lgkmcnt(0)" ::: "memory");
                if (lane == 0) flg[8 + slot] = (unsigned)(c + 1);
#pragma unroll
                for (int a = 0; a < 2; ++a) { St[a][0] = acc[a][1]; St[a][1] = acc[a][2]; }
                if (c >= CTXL / 32) {
                    const int sidx = 32 * c + n32; const int j = dir == 0 ? sidx : (TE + CTXL - 1 - sidx);
                    bf16* yp = Yd + ((size_t)b * T + (j - CTXL)) * 1024 + h * 64 + 4 * hi;
#pragma unroll
                    for (int a = 0; a < 2; ++a) { const Fr2 yf = s2_pack(acc[a][0]); const C16 yt = s2_mm2(yf, IdT, s2_zero());
#pragma unroll
                        for (int g4 = 0; g4 < 4; ++g4) { v2u w; w.x = cvt_pk_bf16(yt[4 * g4], yt[4 * g4 + 1]); w.y = cvt_pk_bf16(yt[4 * g4 + 2], yt[4 * g4 + 3]); *(GAS v2u*)(yp + 32 * a + 8 * g4) = w; } }
                }
            }
        } else {
            const unsigned short* LOw = LO + (size_t)dir * ME * 1024; const unsigned char* LOa = (const unsigned char*)(LO + (size_t)2 * ME * 1024) + (size_t)dir * ME * 1024;
            bf16x8 IdF[2];
#pragma unroll
            for (int s1 = 0; s1 < 2; ++s1) { float t8[8];
#pragma unroll
                for (int i = 0; i < 8; ++i) t8[i] = (16 * s1 + 8 * hi + i == n32) ? 1.0f : 0.0f;
                IdF[s1] = s2_pk8(t8); }
            const bool have = (hi == ((n32 >> 3) & 1));
            for (;;) {
                unsigned cv; { const unsigned ca = (unsigned)(size_t)(lds + LDSCTL_OFF + 96), one = lane == 0 ? 1u : 0u;
                    asm volatile("ds_add_rtn_u32 %0, %1, %2\n\ts_waitcnt lgkmcnt(0)" : "=v"(cv) : "v"(ca), "v"(one) : "memory"); }
                const int c = __builtin_amdgcn_readfirstlane((int)cv);
                if (c >= S2_NCH) break;
                int nq = n32, hq = hi;
#define S2_OPQ() asm volatile("" : "+v"(nq), "+v"(hq))
                S2_OPQ();
                const int j = sc_tok(dir, 32 * c + n32);
                const size_t e = (size_t)b * TE + j;
                const bool hp = (j != 0) && (j != CTXL), hn = (j != CTXL - 1) && (j != TE - 1);
                const bf16* row = P1 + e * P1LD + h * 64 + 8 * hi; const bf16* rowp = hp ? row - P1LD : row; const bf16* rown = hn ? row + P1LD : row;
                const float fp = hp ? 0.5f : 0.f, fn = hn ? 0.5f : 0.f;
                const unsigned short* lw = LOw + e * 1024 + h * 64 + 8 * hi; const unsigned char* la = LOa + e * 1024 + h * 64 + 8 * hi;
                const LAS float* pl = par + 8 * hi;
                v4u RtF[4], KtF[4], CtF[4], BtF[4]; float ptsel[2] = {0.f, 0.f}, ssq = 0.f;
#pragma unroll
                for (int s = 0; s < 4; ++s) {
                    const v4u r0 = *(const GAS v4u*)(row + 16 * s), rp = *(const GAS v4u*)(rowp + 16 * s), rx = *(const GAS v4u*)(rown + 16 * s);
                    const v4u k0 = *(const GAS v4u*)(row + 1024 + 16 * s), kp = *(const GAS v4u*)(rowp + 1024 + 16 * s), kn = *(const GAS v4u*)(rown + 1024 + 16 * s);
                    const v4u ewr = *(const GAS v4u*)(lw + 16 * s); const v2u awr = *(const GAS v2u*)(la + 16 * s);
#pragma unroll
                    for (int w = 0; w < 4; ++w) { float oR[2], oK[2], oC[2], oB[2];
                        const LAS float* plw = pl + 16 * s + 2 * w; asm volatile("" : "+v"(plw));
#pragma unroll
                        for (int q = 0; q < 2; ++q) { const int i = 2 * w + q, sh = 16 * q;
                            const float r_0 = bf2f((r0[w] >> sh) & 0xffffu), r_p = bf2f((rp[w] >> sh) & 0xffffu), r_n = bf2f((rx[w] >> sh) & 0xffffu);
                            const float k_0 = bf2f((k0[w] >> sh) & 0xffffu), k_p = bf2f((kp[w] >> sh) & 0xffffu), k_n = bf2f((kn[w] >> sh) & 0xffffu);
                            const float mr = plw[q], mk = plw[64 + q], kkw = plw[192 + q], kaw = plw[256 + q];
                            const float rs = r_0 + mr * ((fp * r_p + fn * r_n) - r_0), ksv = k_0 + mk * ((fp * k_p + fn * k_n) - k_0);
                            const float av = (float)((awr[w >> 1] >> (8 * (2 * (w & 1) + q))) & 0xffu) * (1.0f / 255.0f);
                            const float e2 = (q ? f16hi(ewr[w]) : f16lo(ewr[w])) * 1.4426950408889634f;
                            const float Pp2 = s2_prefix32(e2);
                            const float Pt = __shfl(Pp2, lane | 31);
                            if (16 * (s & 1) + 8 * hq + i == nq) ptsel[s >> 1] = Pt;
                            const float g = __builtin_amdgcn_exp2f(-Pp2), gi = __builtin_amdgcn_exp2f(Pp2), gp = __builtin_amdgcn_exp2f(e2 - Pp2);
                            const float kkn = ksv * kkw, be = av * kkn, kd = ksv * ((av - 1.0f) * kaw + 1.0f); ssq += kkn * kkn;
                            oR[q] = rs * g; oK[q] = kd * gi; oC[q] = kkn * gp; oB[q] = be * gi; }
                        RtF[s][w] = cvt_pk_bf16(oR[0], oR[1]); KtF[s][w] = cvt_pk_bf16(oK[0], oK[1]); CtF[s][w] = cvt_pk_bf16(oC[0], oC[1]); BtF[s][w] = cvt_pk_bf16(oB[0], oB[1]);
                        __builtin_amdgcn_sched_barrier(0); }
                }
#define S2_F(X, s) __builtin_bit_cast(bf16x8, X[s])
                { ssq += __shfl_xor(ssq, 32); const float rn = rsqrtf(ssq + 1e-12f);
#pragma unroll
                  for (int s = 0; s < 4; ++s)
#pragma unroll
                      for (int w = 0; w < 4; ++w) { const unsigned x = CtF[s][w], y = BtF[s][w];
                          CtF[s][w] = cvt_pk_bf16(bf2f(x & 0xffffu) * rn, __uint_as_float(x & 0xffff0000u) * rn); BtF[s][w] = cvt_pk_bf16(bf2f(y & 0xffffu) * rn, __uint_as_float(y & 0xffff0000u) * rn); } }
                float gcf[2], gd[2];
#pragma unroll
                for (int nb = 0; nb < 2; ++nb) { const float o = __shfl_xor(ptsel[nb], 32); gcf[nb] = __builtin_amdgcn_exp2f(-(have ? ptsel[nb] : o)); gd[nb] = have ? gcf[nb] : 0.f; }
                Fr2 Pp, PTp, nM1T, N2p; C16 TT, N1;
                { C16 t = s2_zero();
#pragma unroll
                  for (int s = 0; s < 4; ++s) t = S2_MF(S2_F(BtF, s), S2_F(CtF, s), t);
#pragma unroll
                  for (int r = 0; r < 16; ++r) t[r] = (S2_ROW(r, hq) < nq) ? -t[r] : 0.f;
                  Pp = s2_pack(t); }
                __builtin_amdgcn_sched_barrier(0); S2_OPQ();
                { C16 t = s2_zero();
#pragma unroll
                  for (int s = 0; s < 4; ++s) t = S2_MF(S2_F(CtF, s), S2_F(BtF, s), t);
#pragma unroll
                  for (int r = 0; r < 16; ++r) t[r] = (nq < S2_ROW(r, hq)) ? -t[r] : 0.f;
                  PTp = s2_pack(t);
#pragma unroll
                  for (int r = 0; r < 16; ++r) t[r] += (S2_ROW(r, hq) == nq) ? 1.0f : 0.f;
                  TT = t; }
                __builtin_amdgcn_sched_barrier(0); S2_OPQ();
                { C16 t = s2_zero();
#pragma unroll
                  for (int s = 0; s < 4; ++s) t = S2_MF(S2_F(CtF, s), S2_F(KtF, s), t);
#pragma unroll
                  for (int r = 0; r < 16; ++r) t[r] = (nq < S2_ROW(r, hq)) ? -t[r] : 0.f;
                  nM1T = s2_pack(t); }
                __builtin_amdgcn_sched_barrier(0); S2_OPQ();
                { C16 t = s2_zero();
#pragma unroll
                  for (int s = 0; s < 4; ++s) t = S2_MF(S2_F(BtF, s), S2_F(RtF, s), t);
#pragma unroll
                  for (int r = 0; r < 16; ++r) t[r] = (S2_ROW(r, hq) <= nq) ? t[r] : 0.f;
                  N2p = s2_pack(t); }
                __builtin_amdgcn_sched_barrier(0); S2_OPQ();
                { C16 t = s2_zero();
#pragma unroll
                  for (int s = 0; s < 4; ++s) t = S2_MF(S2_F(KtF, s), S2_F(RtF, s), t);
#pragma unroll
                  for (int r = 0; r < 16; ++r) t[r] = (S2_ROW(r, hq) <= nq) ? t[r] : 0.f;
                  N1 = t; }
                __builtin_amdgcn_sched_barrier(0); S2_OPQ();
#pragma unroll
                for (int lv = 0; lv < 4; ++lv) {
                    const Fr2 P2p = s2_pack(s2_mm2(PTp, Pp, s2_zero()));
                    if (lv < 3) PTp = s2_pack(s2_mm2(Pp, PTp, s2_zero()));
                    TT = s2_mm2(P2p, s2_pack(TT), TT);
                    Pp = P2p;
                    __builtin_amdgcn_sched_barrier(0);
                }
                const Fr2 TTp = s2_pack(TT);
                Fr2 Xp[3];
                Xp[0] = s2_pack(s2_mm2(TTp, N2p, s2_zero()));
#pragma unroll
                for (int nb = 0; nb < 2; ++nb) { C16 BtL = S2_MF(S2_F(BtF, 2 * nb), IdF[0], s2_zero()); BtL = S2_MF(S2_F(BtF, 2 * nb + 1), IdF[1], BtL);
                    Xp[1 + nb] = s2_pack(s2_mm2(TTp, s2_pack(BtL), s2_zero()), gcf[nb]); }
                __builtin_amdgcn_sched_barrier(0);
                const int slot = c % S2_NS; LAS unsigned char* sb = lds + slot * S2_SLOT;
                if (c >= S2_NS) { unsigned sp = 0; const unsigned need = (unsigned)(c - S2_NS + 1);
                    while (s2_poll(flg + 8 + slot) < need) { __builtin_amdgcn_s_sleep(1); if (++sp > (1u << 24)) break; } }
                asm volatile("" ::: "memory");
#pragma unroll
                for (int mb = 0; mb < 2; ++mb) {
                    C16 CtL = S2_MF(S2_F(CtF, 2 * mb), IdF[0], s2_zero()); CtL = S2_MF(S2_F(CtF, 2 * mb + 1), IdF[1], CtL);
                    const Fr2 nCt = s2_pack(CtL, -1.0f);
#pragma unroll
                    for (int nb = 0; nb < 3; ++nb) {
                        C16 acc = s2_zero();
                        if (nb == 0) { acc = S2_MF(IdF[0], S2_F(RtF, 2 * mb), acc); acc = S2_MF(IdF[1], S2_F(RtF, 2 * mb + 1), acc); }
                        else if (nb == 1 + mb) {
#pragma unroll
                            for (int s1 = 0; s1 < 2; ++s1) { float t8[8];
#pragma unroll
                                for (int i = 0; i < 8; ++i) t8[i] = (16 * s1 + 8 * hq + i == nq) ? gd[mb] : 0.0f;
                                acc = S2_MF(IdF[s1], s2_pk8(t8), acc); } }
                        acc = s2_mm2(nCt, Xp[nb], acc);
                        const Fr2 o = s2_pack(acc);
                        *(LAS bf16x8*)(sb + ((nb * 4 + 2 * mb + 0) * 64 + lane) * 16) = o.k[0]; *(LAS bf16x8*)(sb + ((nb * 4 + 2 * mb + 1) * 64 + lane) * 16) = o.k[1];
                        __builtin_amdgcn_sched_barrier(0);
                    }
                }
                Fr2 VsL[2];
#pragma unroll
                for (int nb = 0; nb < 2; ++nb) { C16 t = s2_zero();
#pragma unroll
                    for (int s1 = 0; s1 < 2; ++s1) { const int s = 2 * nb + s1;
                        const v4u v0 = *(const GAS v4u*)(row + 2048 + 16 * s), vp = *(const GAS v4u*)(rowp + 2048 + 16 * s), vx = *(const GAS v4u*)(rown + 2048 + 16 * s);
                        const LAS float* plw = pl + 128 + 16 * s; asm volatile("" : "+v"(plw));
                        v4u vf;
#pragma unroll
                        for (int w = 0; w < 4; ++w) { float ov[2];
#pragma unroll
                            for (int q = 0; q < 2; ++q) { const int sh = 16 * q; const float v_0 = bf2f((v0[w] >> sh) & 0xffffu), v_p = bf2f((vp[w] >> sh) & 0xffffu), v_n = bf2f((vx[w] >> sh) & 0xffffu);
                                ov[q] = v_0 + plw[2 * w + q] * ((fp * v_p + fn * v_n) - v_0); }
                            vf[w] = cvt_pk_bf16(ov[0], ov[1]); }
                        t = S2_MF(__builtin_bit_cast(bf16x8, vf), IdF[s1], t); }
                    VsL[nb] = s2_pack(t); }
#pragma unroll
                for (int mz = 0; mz < 3; ++mz) {
                    C16 Wb;
                    if (mz == 0) Wb = N1; else { Wb = S2_MF(S2_F(KtF, 2 * (mz - 1)), IdF[0], s2_zero()); Wb = S2_MF(S2_F(KtF, 2 * (mz - 1) + 1), IdF[1], Wb);
#pragma unroll
                        for (int r = 0; r < 16; ++r) Wb[r] *= gcf[mz - 1]; }
                    const Fr2 Wp = s2_pack(s2_mm2(nM1T, Xp[mz], Wb));
#pragma unroll
                    for (int nr = 0; nr < 2; ++nr) { const Fr2 o = s2_pack(s2_mm2(Wp, VsL[nr], s2_zero()));
                        *(LAS bf16x8*)(sb + S2_ZY + (((mz * 2 + nr) * 2 + 0) * 64 + lane) * 16) = o.k[0]; *(LAS bf16x8*)(sb + S2_ZY + (((mz * 2 + nr) * 2 + 1) * 64 + lane) * 16) = o.k[1]; }
                    __builtin_amdgcn_sched_barrier(0);
                }
                {
                    float bon = 0.f;
#pragma unroll
                    for (int s = 0; s < 4; ++s) { const LAS float* plw = pl + 320 + 16 * s; asm volatile("" : "+v"(plw));
#pragma unroll
                        for (int w = 0; w < 4; ++w) { const unsigned x = RtF[s][w], y = KtF[s][w];
                            bon += bf2f(x & 0xffffu) * bf2f(y & 0xffffu) * plw[2 * w] + __uint_as_float(x & 0xffff0000u) * __uint_as_float(y & 0xffff0000u) * plw[2 * w + 1]; } }
                    bon += __shfl_xor(bon, 32);
                    const int jb = sc_tok(dir, 32 * c + nq);
                    if (hq == 0 && jb >= CTXL) ((float*)(F.ws + WS_BON))[((size_t)dir * ML + (size_t)b * T + (jb - CTXL)) * 16 + h] = bon; }
                asm volatile("s_waitcnt lgkmcnt(0)" ::: "memory");
                if (lane == 0) flg[slot] = (unsigned)(c + 1);
            }
#undef S2_F
#undef S2_OPQ
        }
        asm volatile("s_waitcnt vmcnt(0) lgkmcnt(0)" ::: "memory");
        __syncthreads();
        if (F.tid == 0) { __builtin_amdgcn_fence(__ATOMIC_RELEASE, "agent"); asm volatile("s_waitcnt vmcnt(0)" ::: "memory");
            (void)__hip_atomic_fetch_add((unsigned*)(F.ws + WS_CTL) + CW_ATT + 704, 1u, RLX_AGENT); }
    }
}


__device__ __forceinline__ void phase_rcomb(const Frame& F, const Args& A, const int pr = 0, const int tail = 0) {
    const bf16* P1 = (const bf16*)(F.ws + WS_P1);
    const bf16* Gb = (const bf16*)(F.ws + WS_G);
    const float* BON = (const float*)(F.ws + WS_BON);
    bf16* YF = (bf16*)((unsigned char*)A.out + OUT_YF); const bf16* YB = (const bf16*)(F.ws + WS_YB);
    const int lane = F.lane, c0 = 16 * lane;
    struct RowIn { v4u x0[2], xp[2], xn[2], yf[2], yb[2], gg[2]; float cf; };
    auto rload = [&](const int m, RowIn& R) {
        const int b = m / T, t = m - b * T, j = t + CTXL; const size_t e = (size_t)b * TE + j;
        const bool hp = (j != CTXL), hn = (j != TE - 1);
        const bf16* p = P1 + e * P1LD + c0 + 2048;
        R.cf = BON[(size_t)m * 16 + (lane >> 2)] + BON[((size_t)ML + m) * 16 + (lane >> 2)];
#pragma unroll
        for (int hh = 0; hh < 2; ++hh) {
            R.x0[hh] = *(const GAS v4u*)(p + 8 * hh);
            R.xp[hh] = (v4u){0u, 0u, 0u, 0u}; R.xn[hh] = (v4u){0u, 0u, 0u, 0u};
            if (hp) R.xp[hh] = *(const GAS v4u*)(p - P1LD + 8 * hh);
            if (hn) R.xn[hh] = *(const GAS v4u*)(p + P1LD + 8 * hh);
            R.yf[hh] = *(const GAS v4u*)(YF + (size_t)m * 1024 + c0 + 8 * hh); R.yb[hh] = *(const GAS v4u*)(YB + (size_t)m * 1024 + c0 + 8 * hh); R.gg[hh] = *(const GAS v4u*)(Gb + e * 1024 + c0 + 8 * hh);
        }
    };
    auto rfin = [&](const int m, const RowIn& R) {
        const float cf = R.cf;
        float v[16];
#pragma unroll
        for (int hh = 0; hh < 2; ++hh) {
            const v4u x0 = R.x0[hh], xp = R.xp[hh], xn = R.xn[hh];
            const f32x4 mu0 = *(const f32x4*)(A.in[9] + 2048 + c0 + 8 * hh), mu1 = *(const f32x4*)(A.in[9] + 2048 + c0 + 8 * hh + 4);
#pragma unroll
            for (int w = 0; w < 4; ++w) {
                const float a0 = bf2f(x0[w] & 0xffffu), a1 = bf2f(x0[w] >> 16);
                const float p0 = bf2f(xp[w] & 0xffffu), p1 = bf2f(xp[w] >> 16), n0 = bf2f(xn[w] & 0xffffu), n1 = bf2f(xn[w] >> 16);
                const float m0 = (w < 2) ? mu0[2 * w] : mu1[2 * w - 4], m1 = (w < 2) ? mu0[2 * w + 1] : mu1[2 * w - 3];
                v[8 * hh + 2 * w] = a0 + m0 * (0.5f * (p0 + n0) - a0); v[8 * hh + 2 * w + 1] = a1 + m1 * (0.5f * (p1 + n1) - a1);
            }
        }
        float y[16], g[16];
#pragma unroll
        for (int hh = 0; hh < 2; ++hh) {
            const v4u yf = R.yf[hh], yb = R.yb[hh], gg = R.gg[hh];
#pragma unroll
            for (int w = 0; w < 4; ++w) { y[8 * hh + 2 * w] = bf2f(yf[w] & 0xffffu) + bf2f(yb[w] & 0xffffu); y[8 * hh + 2 * w + 1] = bf2f(yf[w] >> 16) + bf2f(yb[w] >> 16);
                g[8 * hh + 2 * w] = bf2f(gg[w] & 0xffffu); g[8 * hh + 2 * w + 1] = bf2f(gg[w] >> 16); }
        }
        float s = 0.f;
#pragma unroll
        for (int i = 0; i < 16; ++i) s += y[i];
        s += __shfl_xor(s, 1); s += __shfl_xor(s, 2);
        const float mean = s * (1.0f / 64.0f); float q2 = 0.f;
#pragma unroll
        for (int i = 0; i < 16; ++i) { const float d = y[i] - mean; q2 += d * d; }
        q2 += __shfl_xor(q2, 1); q2 += __shfl_xor(q2, 2);
        const float rstd = rsqrtf(q2 * (1.0f / 64.0f) + 64e-5f);
        float o[16];
#pragma unroll
        for (int i = 0; i < 16; ++i) { const float yn = (y[i] - mean) * rstd * A.in[18][c0 + i] + A.in[19][c0 + i]; o[i] = (yn + cf * v[i]) * g[i]; }
#pragma unroll
        for (int hh = 0; hh < 2; ++hh) { v4u w; w.x = cvt_pk_bf16(o[8 * hh], o[8 * hh + 1]); w.y = cvt_pk_bf16(o[8 * hh + 2], o[8 * hh + 3]); w.z = cvt_pk_bf16(o[8 * hh + 4], o[8 * hh + 5]); w.w = cvt_pk_bf16(o[8 * hh + 6], o[8 * hh + 7]);
            *(GAS v4u*)((pr ? (bf16*)(F.ws + WS_VT) : YF) + (size_t)m * 1024 + c0 + 8 * hh) = w; }
    };
    auto row = [&](const int m) { RowIn R; rload(m, R); rfin(m, R); };
    if (!tail) { for (int m = F.gw; m < ML; m += F.ngw) row(m); return; }
    unsigned* ctl = (unsigned*)(F.ws + WS_CTL) + CW_ATT;
    volatile LAS unsigned* unw = (volatile LAS unsigned*)(F.lds + LDSCTL_OFF + 256);
    __syncthreads();
    if (F.tid == 0) { unsigned sp = 0; while (__hip_atomic_load(ctl + 704, RLX_AGENT) < 128u) { __builtin_amdgcn_s_sleep(4); if (++sp > (1u << 22)) break; }
        __builtin_amdgcn_fence(__ATOMIC_ACQUIRE, "agent"); asm volatile("s_waitcnt vmcnt(0)" ::: "memory"); }
    __syncthreads();
    for (;;) {
        __syncthreads();
        if (F.tid == 0) unw[0] = __hip_atomic_fetch_add(ctl + 768, 64u, RLX_AGENT);
        __syncthreads();
        const int r0 = (int)unw[0];
        if (r0 >= ML) break;
        { const int m0 = r0 + F.wave * 8; RowIn ra, rb;
          rload(m0, ra);
#pragma unroll 1
          for (int k = 0; k < 8; k += 2) { rload(m0 + k + 1, rb); rfin(m0 + k, ra); if (k + 2 < 8) rload(m0 + k + 2, ra); rfin(m0 + k + 1, rb); } }
    }
}

constexpr int AT_K = 0, AT_V = 16384, AT_BUF = 32768;
__device__ __forceinline__ void phase_attn(const Frame& F, const Args& A) {
    const float* sm = (const float*)(F.ws + WS_SMALL);
    const bf16* P1 = (const bf16*)(F.ws + WS_P1); const bf16* Vt = (const bf16*)(F.ws + WS_VT); bf16* YD = (bf16*)(F.ws + WS_YD);
    const float lam = sm[SM_MISC + 0], smax2 = sm[SM_MISC + 1];
    const int tid = F.tid, lane = F.lane, wid = F.wave, r32 = lane & 31, hi = lane >> 5, map = wid & 1, qg = wid >> 1;
    const int pir = (r32 & 0x13) | ((r32 & 4) << 1) | ((r32 & 8) >> 1);
    LAS unsigned char* lds = F.lds;
    for (int un = F.bid; un < NB * 8 * 64; un += F.G) {
        const int qt = un & 63, h = (un >> 6) & 7, b = un >> 9;
        const bf16* Kg = P1 + (size_t)b * TE * P1LD + PK + h * 128;
        const bf16* Vg = Vt + ((size_t)b * 1024 + h * 128) * TE;
        const bf16* ksrc[2]; const bf16* vsrc[2]; int kdst[2], vdst[2];
#pragma unroll
        for (int i = 0; i < 2; ++i) { const int p = tid + 512 * i; const int key = p >> 4, c16 = p & 15; ksrc[i] = Kg + (size_t)key * P1LD + c16 * 8; kdst[i] = AT_K + (c16 >> 3) * 8192 + (c16 & 7) * 1024 + key * 16;
            const int dv = p >> 3, c = p & 7; vsrc[i] = Vg + (size_t)dv * TE + c * 8; vdst[i] = AT_V + dv * 128 + ((c ^ ((dv >> 1) & 7)) * 16); }
        const size_t erow = (size_t)b * TE + CTXL + qt * 128 + qg * 32 + r32;
        bf16x8 qr[4];
#pragma unroll
        for (int d0 = 0; d0 < 4; ++d0) qr[d0] = *(const GAS bf16x8*)(P1 + erow * P1LD + PQ + h * 128 + map * 64 + d0 * 16 + hi * 8);
        f32x16 o[4];
#pragma unroll
        for (int vb = 0; vb < 4; ++vb)
#pragma unroll
            for (int r = 0; r < 16; ++r) o[vb][r] = 0.f;
        float lsum = 0.f;
        f32x16 negm;
#pragma unroll
        for (int r = 0; r < 16; ++r) negm[r] = -smax2;
        v4u kreg[2], vreg[2];
#pragma unroll
        for (int i = 0; i < 2; ++i) { kreg[i] = *(const GAS v4u*)(ksrc[i]); vreg[i] = *(const GAS v4u*)(vsrc[i]); }
        __syncthreads();
#pragma unroll
        for (int i = 0; i < 2; ++i) { *(LAS v4u*)(lds + kdst[i]) = kreg[i]; *(LAS v4u*)(lds + vdst[i]) = vreg[i]; }
        __syncthreads();
        constexpr int NTILE = TE / 64;
        for (int tI = 0; tI < NTILE; ++tI) {
            const int cur = (tI & 1) * AT_BUF, nxb = ((tI + 1) & 1) * AT_BUF;
            if (tI + 1 < NTILE) {
#pragma unroll
                for (int i = 0; i < 2; ++i) { kreg[i] = *(const GAS v4u*)(ksrc[i] + (size_t)(tI + 1) * 64 * P1LD); vreg[i] = *(const GAS v4u*)(vsrc[i] + (tI + 1) * 64); }
            }
            const LAS unsigned char* kb = lds + cur + AT_K + map * 8192 + hi * 1024 + pir * 16;
            f32x16 s0 = negm, s1 = negm;
#pragma unroll
            for (int d0 = 0; d0 < 4; ++d0) {
                const bf16x8 k0 = *(const LAS bf16x8*)(kb + d0 * 2048), k1 = *(const LAS bf16x8*)(kb + d0 * 2048 + 512);
                s0 = __builtin_amdgcn_mfma_f32_32x32x16_bf16(k0, qr[d0], s0, 0, 0, 0);
                s1 = __builtin_amdgcn_mfma_f32_32x32x16_bf16(k1, qr[d0], s1, 0, 0, 0);
            }
            float ps = 0.f;
#pragma unroll
            for (int r = 0; r < 16; ++r) { s0[r] = __builtin_amdgcn_exp2f(s0[r]); s1[r] = __builtin_amdgcn_exp2f(s1[r]); ps += s0[r] + s1[r]; }
            lsum += ps;
            v4u pw[4];
#pragma unroll
            for (int q = 0; q < 4; ++q) { pw[0][q] = cvt_pk_bf16(s0[2 * q], s0[2 * q + 1]); pw[1][q] = cvt_pk_bf16(s0[8 + 2 * q], s0[8 + 2 * q + 1]);
                pw[2][q] = cvt_pk_bf16(s1[2 * q], s1[2 * q + 1]); pw[3][q] = cvt_pk_bf16(s1[8 + 2 * q], s1[8 + 2 * q + 1]); }
#pragma unroll
            for (int vb = 0; vb < 4; ++vb) { const int dv = 32 * vb + r32; const LAS unsigned char* vp = lds + cur + AT_V + dv * 128; const int sw = (dv >> 1) & 7;
#pragma unroll
                for (int s = 0; s < 4; ++s) { const bf16x8 vf = *(const LAS bf16x8*)(vp + (((2 * s + hi) ^ sw) * 16));
                    o[vb] = __builtin_amdgcn_mfma_f32_32x32x16_bf16(vf, __builtin_bit_cast(bf16x8, pw[s]), o[vb], 0, 0, 0); } }
            if (tI + 1 < NTILE) {
#pragma unroll
                for (int i = 0; i < 2; ++i) { *(LAS v4u*)(lds + nxb + kdst[i]) = kreg[i]; *(LAS v4u*)(lds + nxb + vdst[i]) = vreg[i]; }
            }
            __syncthreads();
        }
        lsum += __shfl_xor(lsum, 32);
        const float inv = 1.0f / lsum;
        LAS float* ex = (LAS float*)lds + qg * 4096;
        if (map == 1) {
#pragma unroll
            for (int vb = 0; vb < 4; ++vb)
#pragma unroll
                for (int r = 0; r < 16; ++r) { const int dv = 32 * vb + (r & 3) + 8 * (r >> 2) + 4 * hi; ex[dv * 32 + r32] = o[vb][r] * inv; }
        }
        __syncthreads();
        if (map == 0) {
            float ss = 0.f;
#pragma unroll
            for (int vb = 0; vb < 4; ++vb)
#pragma unroll
                for (int r = 0; r < 16; ++r) { const int dv = 32 * vb + (r & 3) + 8 * (r >> 2) + 4 * hi; const float d = o[vb][r] * inv - lam * ex[dv * 32 + r32]; o[vb][r] = d; ss += d * d; }
            ss += __shfl_xor(ss, 32);
            const float rn = rsqrtf(ss * (1.0f / 128.0f) + 1e-5f) * 0.8f;
            bf16* orow = YD + ((size_t)b * T + qt * 128 + qg * 32 + r32) * 1024 + h * 128;
#pragma unroll
            for (int vb = 0; vb < 4; ++vb)
#pragma unroll
                for (int g4 = 0; g4 < 4; ++g4) { const int dv = 32 * vb + 8 * g4 + 4 * hi; const f32x4 sg = *(const f32x4*)(A.in[23] + dv);
                    v2u w; w.x = cvt_pk_bf16(o[vb][4 * g4] * rn * sg[0], o[vb][4 * g4 + 1] * rn * sg[1]); w.y = cvt_pk_bf16(o[vb][4 * g4 + 2] * rn * sg[2], o[vb][4 * g4 + 3] * rn * sg[3]);
                    *(GAS v2u*)(orow + dv) = w; }
        }
        __syncthreads();
    }
}

constexpr int LW_I1 = 32 * 64, LW_I2 = 16 * 32, LW_I3 = 32 * 32, LW_IE1 = 32 * 8 * 32, LW_IE2 = 8 * 32 * 32;
constexpr int LW_NIT = LW_I1 + 2 * LW_I2 + LW_I3 + 2 * LW_IE1 + LW_IE2;
__device__ __forceinline__ void latew_item(const Frame& F, const Args& A, int it, LAS float* scr, int lane) {
    bf16* WGT = (bf16*)(F.ws + WS_WGT); bf16* WPA = (bf16*)(F.ws + WS_WPA); bf16* WPB = (bf16*)(F.ws + WS_WPB); bf16* WOUT = (bf16*)(F.ws + WS_WOUT);
    bf16* E13 = (bf16*)((unsigned char*)A.out + OUT_EW13); bf16* E2 = (bf16*)((unsigned char*)A.out + OUT_EW2);
    int r = it;
    if (r < LW_I1) { tr_job64(r, A.in[8], NIN, 6784, 4096, WGT, 2048, 0, scr, lane); return; } r -= LW_I1;
    if (r < LW_I2) { tr_job64(r, A.in[24], 2048, 0, 2048, WPA, 1024, 0, scr, lane); return; } r -= LW_I2;
    if (r < LW_I2) { tr_job64(r, A.in[25], 2048, 0, 2048, WPB, 1024, 0, scr, lane); return; } r -= LW_I2;
    if (r < LW_I3) { tr_job64(r, A.in[26], 2048, 0, 2048, WOUT, 2048, 0, scr, lane); return; } r -= LW_I3;
    if (r < 2 * LW_IE1) {
        const int which = r >= LW_IE1 ? 1 : 0; if (which) r -= LW_IE1;
        const int e = r / 256, q = r - e * 256, kb = q >> 3, nb = q & 7, n0 = 64 * nb;
        const float* W = A.in[which ? 32 : 31] + (size_t)e * 2048 * 512;
        tr_item64(W, 512, n0, 64 * kb, E13, 2048, e * 1024 + (n0 >> 7) * 256 + which * 128 + (n0 & 127), scr, lane); return; }
    r -= 2 * LW_IE1;
    { const int e = r / 256, q = r - e * 256, kb = q >> 5, nb = q & 31;
      tr_item64(A.in[33] + (size_t)e * 512 * 2048, 2048, 64 * nb, 64 * kb, E2, 512, e * 2048 + 64 * nb, scr, lane); }
}

constexpr int A2_K = 0, A2_V = 65536, A2_SLOT = 16384, A2_SGL = 133120;
__device__ __forceinline__ void phase_attn2(const Frame& F, const Args& A) {
    const float* sm = (const float*)(F.ws + WS_SMALL);
    const bf16* P1 = (const bf16*)(F.ws + WS_P1); const bf16* Vt = (const bf16*)(F.ws + WS_VT); bf16* YD = (bf16*)(F.ws + WS_YD);
    const int lane = F.lane, wid = F.wave, r32 = lane & 31, hi = lane >> 5, map = wid & 1, qg = wid >> 1;
    const int pir = (r32 & 0x13) | ((r32 & 4) << 1) | ((r32 & 8) >> 1);
    LAS unsigned char* lds = F.lds;
    __syncthreads();
    if (F.tid < 128) ((LAS float*)(lds + A2_SGL))[F.tid] = A.in[23][F.tid];
    unsigned voffK0, voffV0;
    { const int p = 2 * wid;
        { const int key = 4 * p + (lane >> 4), pos = lane & 15, c = pos ^ (key & 15); voffK0 = (unsigned)(key * P1LD + c * 8) * 2u; }
        { const int dv = 8 * p + (lane >> 3), pos = lane & 7, c = pos ^ ((dv >> 1) & 7); voffV0 = (unsigned)(dv * TE + c * 8) * 2u; } }
    const f32x16 negm = {0.f, 0.f, 0.f, 0.f, 0.f, 0.f, 0.f, 0.f, 0.f, 0.f, 0.f, 0.f, 0.f, 0.f, 0.f, 0.f};
    const int koff = pir * 256, ksw = pir & 15;
    const int vrow = r32 * 128, vsw = (r32 >> 1) & 7;
    const int kad0 = A2_K + koff + (((map * 8 + hi) ^ ksw) * 16), vad0 = A2_V + vrow + ((hi ^ vsw) * 16);
    constexpr int NT = TE / 64;
#define A2_DMA_K(t_) do { const char* base_ = (const char*)(Kg + (size_t)(t_) * 64 * P1LD); const int dst_ = A2_K + ((t_) & 3) * A2_SLOT + wid * 2048; \
        __builtin_amdgcn_global_load_lds((const unsigned*)(base_ + voffK0), (LAS unsigned*)(lds + dst_), 16, 0, 0); \
        __builtin_amdgcn_global_load_lds((const unsigned*)(base_ + ((voffK0 ^ 64u) + 4u * P1LD * 2u)), (LAS unsigned*)(lds + dst_ + 1024), 16, 0, 0); } while (0)
#define A2_DMA_V(t_) do { const char* base_ = (const char*)(Vg + (size_t)(t_) * 64); const int dst_ = A2_V + ((t_) % 3) * A2_SLOT + wid * 2048; \
        __builtin_amdgcn_global_load_lds((const unsigned*)(base_ + voffV0), (LAS unsigned*)(lds + dst_), 16, 0, 0); \
        __builtin_amdgcn_global_load_lds((const unsigned*)(base_ + ((voffV0 ^ 64u) + 8u * TE * 2u)), (LAS unsigned*)(lds + dst_ + 1024), 16, 0, 0); } while (0)
#define A2_SB() __builtin_amdgcn_sched_barrier(0)
#define A2_KF(t_, d0_, blk_) (*(const LAS bf16x8*)(lds + (((t_) & 3) * A2_SLOT + (kad0 ^ ((d0_) << 5))) + (blk_) * 8192))
#define A2_VF(t_, s_, vb_) (*(const LAS bf16x8*)(lds + (((t_) % 3) * A2_SLOT + (vad0 ^ ((s_) << 5))) + (vb_) * 4096))
    unsigned* attcnt = (unsigned*)(F.ws + WS_CTL) + CW_ATT;
    volatile LAS unsigned* unw = (volatile LAS unsigned*)(lds + LDSCTL_OFF + 256);
    for (;;) {
        __syncthreads();
        if (F.tid == 0) {
            unsigned x = xb_xcc_id() & 7u, got = 0xffffffffu;
            for (int tr = 0; tr < 8; ++tr) { const unsigned li = __hip_atomic_fetch_add(attcnt + 128 + 64 * x, 1u, RLX_AGENT); if (li < 256u) { got = (x << 8) | li; break; } x = (x + 1u) & 7u; }
            unw[0] = got; }
        __syncthreads();
        const unsigned ug = unw[0];
        if (ug == 0xffffffffu) break;
        const int qt = (int)(ug & 63u), h = (int)(ug >> 8), b = (int)((ug >> 6) & 3u);
        const bf16* Kg = P1 + (size_t)b * TE * P1LD + PK + h * 128;
        const bf16* Vg = Vt + ((size_t)b * 1024 + h * 128) * TE;
        __syncthreads();
        A2_DMA_K(0); A2_DMA_V(0); A2_DMA_K(1); A2_DMA_K(2);
        const size_t erow = (size_t)b * TE + CTXL + qt * 128 + qg * 32 + r32;
        bf16x8 qr[4];
#pragma unroll
        for (int d0 = 0; d0 < 4; ++d0) qr[d0] = *(const GAS bf16x8*)(P1 + erow * P1LD + PQ + h * 128 + map * 64 + d0 * 16 + hi * 8);
        f32x16 o[4];
#pragma unroll
        for (int vb = 0; vb < 4; ++vb)
#pragma unroll
            for (int r = 0; r < 16; ++r) o[vb][r] = 0.f;
        float lsum = 0.f;
        __builtin_amdgcn_s_waitcnt(0);
        __builtin_amdgcn_s_barrier(); asm volatile("" ::: "memory");
        f32x16 c0, c1; v4u pw[4];
        A2_DMA_K(3); A2_DMA_V(1);
        c0 = __builtin_amdgcn_mfma_f32_32x32x16_bf16(A2_KF(0, 0, 0), qr[0], negm, 0, 0, 0); c1 = __builtin_amdgcn_mfma_f32_32x32x16_bf16(A2_KF(0, 0, 1), qr[0], negm, 0, 0, 0);
#pragma unroll
        for (int d0 = 1; d0 < 4; ++d0) { c0 = __builtin_amdgcn_mfma_f32_32x32x16_bf16(A2_KF(0, d0, 0), qr[d0], c0, 0, 0, 0); c1 = __builtin_amdgcn_mfma_f32_32x32x16_bf16(A2_KF(0, d0, 1), qr[d0], c1, 0, 0, 0); }
#pragma unroll
        for (int q = 0; q < 8; ++q) { const float e0 = __builtin_amdgcn_exp2f(c0[2 * q]), e1 = __builtin_amdgcn_exp2f(c0[2 * q + 1]), e2 = __builtin_amdgcn_exp2f(c1[2 * q]), e3 = __builtin_amdgcn_exp2f(c1[2 * q + 1]);
            lsum += (e0 + e1) + (e2 + e3); pw[q >> 2][q & 3] = cvt_pk_bf16(e0, e1); pw[2 + (q >> 2)][q & 3] = cvt_pk_bf16(e2, e3); }
        bf16x8 k0_ = A2_KF(1, 0, 0), k1_ = A2_KF(1, 0, 1), k2_ = A2_KF(1, 1, 0), k3_ = A2_KF(1, 1, 1);
        asm volatile("s_waitcnt vmcnt(4) lgkmcnt(0)" ::: "memory"); __builtin_amdgcn_s_barrier(); asm volatile("" ::: "memory");
#define A2_MF(C, KFR, Q, CIN) C = __builtin_amdgcn_mfma_f32_32x32x16_bf16(KFR, Q, CIN, 0, 0, 0)
#define A2_PVG(VR, OV, PWO, X, B2, PWN, H) do { OV = __builtin_amdgcn_mfma_f32_32x32x16_bf16(VR, __builtin_bit_cast(bf16x8, PWO), OV, 0, 0, 0); \
            { const float e0_ = __builtin_amdgcn_exp2f(X[(B2)]), e1_ = __builtin_amdgcn_exp2f(X[(B2) + 1]); sacc2_ += (f32x2){e0_, e1_}; unsigned pk_ = cvt_pk_bf16(e0_, e1_); \
              asm volatile("" : "+v"(pk_), "+v"(sacc2_)); PWN[(H)] = pk_; } } while (0)
        for (int t = 1; t < NT; ++t) {
            int nissue_ = 0;
            bf16x8 k4_, k5_, k6_, k7_, v0_, v1_, v2_, v3_;
            A2_MF(c0, k0_, qr[0], negm); k4_ = A2_KF(t, 2, 0); A2_SB();
            A2_MF(c1, k1_, qr[0], negm); k5_ = A2_KF(t, 2, 1); A2_SB();
            A2_MF(c0, k2_, qr[1], c0);   k6_ = A2_KF(t, 3, 0); A2_SB();
            A2_MF(c1, k3_, qr[1], c1);   k7_ = A2_KF(t, 3, 1); A2_SB();
            A2_MF(c0, k4_, qr[2], c0);   v0_ = A2_VF(t - 1, 0, 0); A2_SB();
            A2_MF(c1, k5_, qr[2], c1);   v1_ = A2_VF(t - 1, 0, 1); A2_SB();
            A2_MF(c0, k6_, qr[3], c0);   v2_ = A2_VF(t - 1, 0, 2); A2_SB();
            A2_MF(c1, k7_, qr[3], c1);   v3_ = A2_VF(t - 1, 0, 3); A2_SB();
            if (t + 3 < NT) { A2_DMA_K(t + 3); nissue_ += 2; } if (t + 1 < NT) { A2_DMA_V(t + 1); nissue_ += 2; } A2_SB();
            v4u pn0_, pn1_, pn2_, pn3_; f32x2 sacc2_ = {0.f, 0.f};
            A2_PVG(v0_, o[0], pw[0], c0, 0, pn0_, 0);  A2_SB();
            A2_PVG(v1_, o[1], pw[0], c0, 2, pn0_, 1);  v0_ = A2_VF(t - 1, 1, 0); A2_SB();
            A2_PVG(v2_, o[2], pw[0], c0, 4, pn0_, 2);  v1_ = A2_VF(t - 1, 1, 1); A2_SB();
            A2_PVG(v3_, o[3], pw[0], c0, 6, pn0_, 3);  v2_ = A2_VF(t - 1, 1, 2); A2_SB();
            A2_PVG(v0_, o[0], pw[1], c0, 8, pn1_, 0);  v3_ = A2_VF(t - 1, 1, 3); A2_SB();
            A2_PVG(v1_, o[1], pw[1], c0, 10, pn1_, 1); v0_ = A2_VF(t - 1, 2, 0); A2_SB();
            A2_PVG(v2_, o[2], pw[1], c0, 12, pn1_, 2); v1_ = A2_VF(t - 1, 2, 1); A2_SB();
            A2_PVG(v3_, o[3], pw[1], c0, 14, pn1_, 3); v2_ = A2_VF(t - 1, 2, 2); A2_SB();
            A2_PVG(v0_, o[0], pw[2], c1, 0, pn2_, 0);  v3_ = A2_VF(t - 1, 2, 3); A2_SB();
            A2_PVG(v1_, o[1], pw[2], c1, 2, pn2_, 1);  v0_ = A2_VF(t - 1, 3, 0); A2_SB();
            A2_PVG(v2_, o[2], pw[2], c1, 4, pn2_, 2);  v1_ = A2_VF(t - 1, 3, 1); A2_SB();
            A2_PVG(v3_, o[3], pw[2], c1, 6, pn2_, 3);  v2_ = A2_VF(t - 1, 3, 2); A2_SB();
            A2_PVG(v0_, o[0], pw[3], c1, 8, pn3_, 0);  v3_ = A2_VF(t - 1, 3, 3); A2_SB();
            A2_PVG(v1_, o[1], pw[3], c1, 10, pn3_, 1); if (t + 1 < NT) { k0_ = A2_KF(t + 1, 0, 0); k1_ = A2_KF(t + 1, 0, 1); } A2_SB();
            A2_PVG(v2_, o[2], pw[3], c1, 12, pn3_, 2); if (t + 1 < NT) { k2_ = A2_KF(t + 1, 1, 0); k3_ = A2_KF(t + 1, 1, 1); } A2_SB();
            A2_PVG(v3_, o[3], pw[3], c1, 14, pn3_, 3); A2_SB();
            lsum += sacc2_.x + sacc2_.y; pw[0] = pn0_; pw[1] = pn1_; pw[2] = pn2_; pw[3] = pn3_;
            if (nissue_ == 4) asm volatile("s_waitcnt vmcnt(4) lgkmcnt(0)" ::: "memory"); else if (nissue_ == 2) asm volatile("s_waitcnt vmcnt(2) lgkmcnt(0)" ::: "memory"); else asm volatile("s_waitcnt vmcnt(0) lgkmcnt(0)" ::: "memory");
            __builtin_amdgcn_s_barrier(); asm volatile("" ::: "memory");
        }
#pragma unroll
        for (int s = 0; s < 4; ++s)
#pragma unroll
            for (int vb = 0; vb < 4; ++vb) o[vb] = __builtin_amdgcn_mfma_f32_32x32x16_bf16(A2_VF(NT - 1, s, vb), __builtin_bit_cast(bf16x8, pw[s]), o[vb], 0, 0, 0);
        lsum += __shfl_xor(lsum, 32);
        const float inv = 1.0f / lsum;
        asm volatile("s_waitcnt lgkmcnt(0)" ::: "memory"); __builtin_amdgcn_s_barrier(); asm volatile("" ::: "memory");
        LAS float* ex = (LAS float*)lds + qg * 4096;
        if (map == 1) {
#pragma unroll
            for (int vb = 0; vb < 4; ++vb)
#pragma unroll
                for (int r = 0; r < 16; ++r) { const int dv = 32 * vb + (r & 3) + 8 * (r >> 2) + 4 * hi; ex[dv * 32 + r32] = o[vb][r] * inv; }
        }
        asm volatile("s_waitcnt lgkmcnt(0)" ::: "memory"); __builtin_amdgcn_s_barrier(); asm volatile("" ::: "memory");
        if (map == 0) {
            const float lam = sm[SM_MISC + 0];
            float ss = 0.f;
#pragma unroll
            for (int vb = 0; vb < 4; ++vb) {
#pragma unroll
                for (int r = 0; r < 16; ++r) { const int dv = 32 * vb + (r & 3) + 8 * (r >> 2) + 4 * hi; const float d = o[vb][r] * inv - lam * ex[dv * 32 + r32]; o[vb][r] = d; ss += d * d; }
                asm volatile("" : "+v"(ss), "+v"(o[vb])); A2_SB(); }
            ss += __shfl_xor(ss, 32);
            const float rn = rsqrtf(ss * (1.0f / 128.0f) + 1e-5f) * 0.8f;
            bf16* orow = YD + ((size_t)b * T + qt * 128 + qg * 32 + r32) * 1024 + h * 128;
#pragma unroll
            for (int vb = 0; vb < 4; ++vb)
#pragma unroll
                for (int g4 = 0; g4 < 4; ++g4) { const int dv = 32 * vb + 8 * g4 + 4 * hi; const f32x4 sg = *(const LAS f32x4*)(lds + A2_SGL + dv * 4);
                    v2u w; w.x = cvt_pk_bf16(o[vb][4 * g4] * rn * sg[0], o[vb][4 * g4 + 1] * rn * sg[1]); w.y = cvt_pk_bf16(o[vb][4 * g4 + 2] * rn * sg[2], o[vb][4 * g4 + 3] * rn * sg[3]);
                    *(GAS v2u*)(orow + dv) = w; }
        }
    }
    asm volatile("s_waitcnt vmcnt(0) lgkmcnt(0)" ::: "memory");
    __syncthreads();
    { unsigned* cvcnt = attcnt + 64; LAS float* scr = (LAS float*)(lds + wid * 16640);
      for (;;) {
          __syncthreads();
          if (F.tid == 0) unw[0] = __hip_atomic_fetch_add(cvcnt, 16u, RLX_AGENT);
          __syncthreads();
          const int it0 = (int)unw[0];
          if (it0 >= LW_NIT) break;
          { const int it = it0 + wid; if (it < LW_NIT) latew_item(F, A, it, scr, lane); }
          { const int it = it0 + 8 + wid; if (it < LW_NIT) latew_item(F, A, it, scr, lane); }
      } }
    asm volatile("s_waitcnt vmcnt(0) lgkmcnt(0)" ::: "memory");
    __syncthreads();
#undef A2_DMA_K
#undef A2_DMA_V
#undef A2_SB
#undef A2_KF
#undef A2_VF
#undef A2_MF
#undef A2_PVG
}

struct SchedSimple {
    const char* a; const char* b; size_t astep, bstep; int nM, nN, ntk, G, c;
    __device__ __forceinline__ bool next(int i, Unit& u) const { const int L = i * G + c; if (L >= nM * nN) return false; u.kind = 0; pg8::tile_order(L, nM, nN, u.pm, u.pn); return true; }
    __device__ __forceinline__ const char* a_ptr(const Unit& u) const { return a + (size_t)u.pm * astep; }
    __device__ __forceinline__ const char* b_ptr(const Unit& u) const { return b + (size_t)u.pn * bstep; }
    __device__ __forceinline__ int nt(const Unit&) const { return ntk; }
    __device__ __forceinline__ bool keep(const Unit&) const { return false; }
};
template <int MODE> struct EpiMerge {
    bf16* gate; bf16* mix; const float* x; float* out; const float* mod;
    __device__ __forceinline__ void operator()(const f32x4 (&acc)[2][2][4][2], const Unit& u, int wr, int wc, int fr, int fq) const {
        const int row0 = u.pm * 256 + wr * 64 + fr, col0 = u.pn * 256 + wc * 32 + 8 * fq;
#pragma unroll
        for (int ai = 0; ai < 2; ++ai)
#pragma unroll
            for (int m = 0; m < 4; ++m) { const size_t row = (size_t)(row0 + ai * 128 + m * 16);
#pragma unroll
                for (int bj = 0; bj < 2; ++bj) { const int col = col0 + bj * 128; const f32x4 v0 = acc[ai][bj][m][0], v1 = acc[ai][bj][m][1];
                    float v[8] = {v0[0], v0[1], v0[2], v0[3], v1[0], v1[1], v1[2], v1[3]};
                    if (MODE == 0) {
#pragma unroll
                        for (int q = 0; q < 8; ++q) v[q] = sigmoidf_(v[q]);
                        v4u w; w.x = cvt_pk_bf16(v[0], v[1]); w.y = cvt_pk_bf16(v[2], v[3]); w.z = cvt_pk_bf16(v[4], v[5]); w.w = cvt_pk_bf16(v[6], v[7]);
                        *(v4u*)(gate + row * 4096 + col) = w;
                    } else if (MODE == 1 || MODE == 2) {
                        const v4u g = *(const v4u*)(gate + row * 4096 + (MODE == 2 ? 2048 : 0) + col);
                        v4u t = {0u, 0u, 0u, 0u}; if (MODE == 2) t = *(const v4u*)(mix + row * 2048 + col);
                        v4u w;
#pragma unroll
                        for (int q = 0; q < 4; ++q) { const float a = bf2f(g[q] & 0xffffu) * v[2 * q] + bf2f(t[q] & 0xffffu), c = bf2f(g[q] >> 16) * v[2 * q + 1] + bf2f(t[q] >> 16); w[q] = cvt_pk_bf16(a, c); }
                        *(v4u*)(mix + row * 2048 + col) = w;
                    } else {
                        const int b = (int)(row >> 13);
                        const f32x4 x0 = *(const f32x4*)(x + row * 2048 + col), x1 = *(const f32x4*)(x + row * 2048 + col + 4);
                        const f32x4 g0 = *(const f32x4*)(mod + b * 12288 + 4096 + col), g1 = *(const f32x4*)(mod + b * 12288 + 4096 + col + 4);
                        const f32x4 y0 = x0 + g0 * v0, y1 = x1 + g1 * v1; v4u w; w.x = pk_f16(y0[0], y0[1]); w.y = pk_f16(y0[2], y0[3]); w.z = pk_f16(y1[0], y1[1]); w.w = pk_f16(y1[2], y1[3]);
                        *(v4u*)((unsigned short*)out + row * 2048 + col) = w;
                    }
                } }
    }
};

struct SchedGates {
    const char* hx; const char* wgt; int G, c;
    __device__ __forceinline__ bool next(int i, Unit& u) const { const int L = (i >> 1) * G + c; if (L >= 128 * 8) return false; u.kind = 0; pg8::tile_order(L, 128, 8, u.pm, u.pn); u.pn += 8 * (i & 1); return true; }
    __device__ __forceinline__ const char* a_ptr(const Unit& u) const { return hx + (size_t)(u.pm + (u.pm >> 5) + 1) * 256 * 2048 * 2; }
    __device__ __forceinline__ const char* b_ptr(const Unit& u) const { return wgt + (size_t)u.pn * 256 * 2048 * 2; }
    __device__ __forceinline__ int nt(const Unit&) const { return 32; }
    __device__ __forceinline__ bool keep(const Unit&) const { return false; }
};
struct SchedMerge2 {
    const char* yr; const char* yd; const char* wpa; const char* wpb; int G, c;
    __device__ __forceinline__ bool next(int i, Unit& u) const { const int L = (i >> 1) * G + c; if (L >= 128 * 8) return false; u.kind = i & 1; pg8::tile_order(L, 128, 8, u.pm, u.pn); return true; }
    __device__ __forceinline__ const char* a_ptr(const Unit& u) const { return (u.kind ? yd : yr) + (size_t)u.pm * 256 * 1024 * 2; }
    __device__ __forceinline__ const char* b_ptr(const Unit& u) const { return (u.kind ? wpb : wpa) + (size_t)u.pn * 256 * 1024 * 2; }
    __device__ __forceinline__ int nt(const Unit&) const { return 16; }
    __device__ __forceinline__ bool keep(const Unit& u) const { return u.kind == 0; }
};
struct EpiMerge12 {
    const bf16* gate; bf16* mix;
    __device__ __forceinline__ void operator()(f32x4 (&acc)[2][2][4][2], const Unit& u, int wr, int wc, int fr, int fq) const {
        const int row0 = u.pm * 256 + wr * 64 + fr, col0 = u.pn * 256 + wc * 32 + 8 * fq;
#pragma unroll
        for (int ai = 0; ai < 2; ++ai)
#pragma unroll
            for (int m = 0; m < 4; ++m) { const size_t row = (size_t)(row0 + ai * 128 + m * 16);
#pragma unroll
                for (int bj = 0; bj < 2; ++bj) { const int col = col0 + bj * 128;
                    const v4u gb = *(const v4u*)(gate + row * 4096 + 2048 + col);
                    if (u.kind == 0) {
                        const v4u ga = *(const v4u*)(gate + row * 4096 + col);
#pragma unroll
                        for (int q = 0; q < 4; ++q) { const float r0 = bf2f(ga[q] & 0xffffu) * __builtin_amdgcn_rcpf(fmaxf(bf2f(gb[q] & 0xffffu), 1e-30f)), r1 = bf2f(ga[q] >> 16) * __builtin_amdgcn_rcpf(fmaxf(bf2f(gb[q] >> 16), 1e-30f));
                            acc[ai][bj][m][q >> 1][2 * (q & 1)] *= r0; acc[ai][bj][m][q >> 1][2 * (q & 1) + 1] *= r1; }
                    } else {
                        v4u w;
#pragma unroll
                        for (int q = 0; q < 4; ++q) w[q] = cvt_pk_bf16(acc[ai][bj][m][q >> 1][2 * (q & 1)] * bf2f(gb[q] & 0xffffu), acc[ai][bj][m][q >> 1][2 * (q & 1) + 1] * bf2f(gb[q] >> 16));
                        *(v4u*)(mix + row * 2048 + col) = w;
                    }
                } }
    }
};

__device__ __forceinline__ void phase_router2(const Frame& F, const Args& A, const int pr = 0) {
    const float* sm = (const float*)(F.ws + WS_SMALL);
    bf16* H2 = (bf16*)(F.ws + WS_H2);
    unsigned* cnt = (unsigned*)(F.ws + WS_CTL) + CW_CNT + (pr ? 32 : 0);
    unsigned* tokrec = (unsigned*)(F.ws + WS_TOK + (pr ? MiB : 0));
    const int lane = F.lane; const unsigned lo16 = (unsigned)lane * 16u;
    if (F.bid == 0) for (int i = F.tid; i < D / 2; i += 512) ((unsigned*)(H2 + (size_t)ML * D))[i] = 0u;
    unsigned* elist = (unsigned*)(F.ws + WS_GOFF) + (pr ? (size_t)NE * ML : 0);
    __syncthreads();
    { const GAS v4u* src = (const GAS v4u*)(sm + SM_WET) + F.tid; LAS v4u* dst = (LAS v4u*)F.lds + F.tid;
#pragma unroll
      for (int it = 0; it < 16; ++it) dst[512 * it] = src[512 * it]; }
    __syncthreads();
    const float* wg = sm + SM_WRT;
    for (int m = F.gw; m < ML; m += F.ngw) {
        const int b = m / T;
        const float* mod = sm + SM_MOD + b * 12288;
        const GAS v2u* xr = (const GAS v2u*)((const unsigned short*)(F.ws + WS_XN) + (size_t)m * D) + lane;
        f32x4 v[8]; float s = 0.f;
#pragma unroll
        for (int q = 0; q < 8; ++q) { const v2u xh = xr[64 * q]; v[q] = (f32x4){f16lo(xh.x), f16hi(xh.x), f16lo(xh.y), f16hi(xh.y)}; s += (v[q].x * v[q].x + v[q].y * v[q].y) + (v[q].z * v[q].z + v[q].w * v[q].w); }
        const float rstd = rsqrtf(wave_sum(s) * (1.0f / D) + 1e-6f);
        GAS v2u* o8 = (GAS v2u*)(H2 + (size_t)m * D) + lane;
        float gl[4] = {0.f, 0.f, 0.f, 0.f};
#pragma unroll
        for (int q = 0; q < 8; ++q) {
            const f32x4 g = *(const f32x4*)((const char*)A.in[7] + lo16 + q * 1024), sh = *(const f32x4*)((const char*)(mod + 3 * 2048) + lo16 + q * 1024), sc = *(const f32x4*)((const char*)(mod + 4 * 2048) + lo16 + q * 1024);
            v[q] = v[q] * rstd * g * (sc + 1.0f) + sh;
            v2u w; w.x = cvt_pk_bf16(v[q].x, v[q].y); w.y = cvt_pk_bf16(v[q].z, v[q].w); o8[64 * q] = w;
#pragma unroll
            for (int n = 0; n < 4; ++n) { const f32x4 w4 = *(const f32x4*)((const char*)(wg + n * 2048) + lo16 + q * 1024); gl[n] += (v[q].x * w4.x + v[q].y * w4.y) + (v[q].z * w4.z + v[q].w * w4.w); } }
#pragma unroll
        for (int n = 0; n < 4; ++n) gl[n] = wave_sum(gl[n]) + A.in[28][n];
        int gt = 0; float gm = gl[0];
#pragma unroll
        for (int i = 1; i < 4; ++i) if (gl[i] > gm) { gm = gl[i]; gt = i; }
        gt = __builtin_amdgcn_readfirstlane(gt);
        float gs = 0.f;
#pragma unroll
        for (int i = 0; i < 4; ++i) gs += __expf(gl[i] - gm);
        const float pg = 1.0f / gs;
        float el[8];
        const LAS unsigned char* wl = F.lds + (size_t)gt * 8 * 4096 + 8 * lane;
#pragma unroll
        for (int i = 0; i < 8; ++i) { float acc = 0.f;
#pragma unroll
            for (int q = 0; q < 8; ++q) { const v2u w = *(const LAS v2u*)(wl + i * 4096 + 512 * q);
                acc += (v[q].x * f16lo(w.x) + v[q].y * f16hi(w.x)) + (v[q].z * f16lo(w.y) + v[q].w * f16hi(w.y)); }
            asm volatile("" : "+v"(acc)); el[i] = acc; }
#pragma unroll
        for (int i = 0; i < 8; ++i) el[i] = wave_sum(el[i]);
        if (lane == 0) {
#pragma unroll
            for (int i = 0; i < 8; ++i) { const float b0 = A.in[30][i], b1 = A.in[30][8 + i], b2 = A.in[30][16 + i], b3 = A.in[30][24 + i]; el[i] += gt == 0 ? b0 : (gt == 1 ? b1 : (gt == 2 ? b2 : b3)); }
            int i1 = 0; float m1 = el[0];
#pragma unroll
            for (int i = 1; i < 8; ++i) if (el[i] > m1) { m1 = el[i]; i1 = i; }
            int i2 = -1; float m2 = -3.0e38f;
#pragma unroll
            for (int i = 0; i < 8; ++i) if (i != i1 && el[i] > m2) { m2 = el[i]; i2 = i; }
            const float w1 = 1.0f / (1.0f + __expf(m2 - m1)), w2 = 1.0f - w1;
            const int e0 = gt * 8 + i1, e1 = gt * 8 + i2;
            const unsigned p0 = __hip_atomic_fetch_add(cnt + e0 * CNT_STRIDE, 1u, RLX_AGENT), p1 = __hip_atomic_fetch_add(cnt + e1 * CNT_STRIDE, 1u, RLX_AGENT);
            v4u rec; rec.x = (unsigned)e0 | ((unsigned)e1 << 8); rec.y = p0 | (p1 << 16); rec.z = __float_as_uint(pg * w1); rec.w = __float_as_uint(pg * w2);
            *(GAS v4u*)(tokrec + (size_t)m * 4) = rec;
            elist[(size_t)e0 * ML + p0] = (unsigned)m; elist[(size_t)e1 * ML + p1] = (unsigned)m;
        }
    }
}

__device__ __forceinline__ void build_block_table(const Frame& F) {
    volatile LAS unsigned* tab = (volatile LAS unsigned*)(F.lds + LDSCTL_OFF);
    __syncthreads();
    if (F.tid < 64) {
        unsigned* cnt = (unsigned*)(F.ws + WS_CTL) + CW_CNT;
        const int e = F.tid;
        const unsigned c = (e < NE) ? __hip_atomic_load(cnt + e * CNT_STRIDE, RLX_AGENT) : 0u;
        const unsigned nb = (c + 255u) >> 8;
        unsigned incl = nb;
#pragma unroll
        for (int o = 1; o < 64; o <<= 1) { const unsigned t = (unsigned)__shfl_up((int)incl, o); if (e >= o) incl += t; }
        const unsigned st = incl - nb;
        if (e < NE) { tab[1 + e] = st; tab[340 + e] = c;
            for (unsigned q = 0; q < nb && st + q < CAPB; ++q) tab[40 + st + q] = (unsigned)e; }
        unsigned tot = (unsigned)__builtin_amdgcn_readlane((int)incl, NE - 1); if (tot > CAPB) tot = CAPB;
        if (e == 0) { tab[33] = tot; tab[0] = tot; }
    }
    __syncthreads();
}

__device__ __forceinline__ void phase_gather(const Frame& F, const Args& A) {
    build_block_table(F);
    volatile LAS unsigned* tab = (volatile LAS unsigned*)(F.lds + LDSCTL_OFF);
    unsigned* goff = (unsigned*)(F.ws + WS_GOFF);
    const unsigned* tokrec = (const unsigned*)(F.ws + WS_TOK);
    for (int m = F.bid * 512 + F.tid; m < ML; m += F.G * 512) {
        const v4u rec = *(const GAS v4u*)(tokrec + (size_t)m * 4);
        const unsigned e0 = rec.x & 0xffu, e1 = (rec.x >> 8) & 0xffu;
        const unsigned s0 = tab[1 + e0] * 256u + (rec.y & 0xffffu), s1 = tab[1 + e1] * 256u + (rec.y >> 16);
        const unsigned off = (unsigned)m * (unsigned)(D * 2);
        if (s0 < (unsigned)(CAPB * 256)) goff[s0] = off;
        if (s1 < (unsigned)(CAPB * 256)) goff[s1] = off;
    }
}

struct SchedMoe {
    const char* a; const char* b; size_t astep, bstep; int npn, ntk, G, c; volatile LAS unsigned* tab;
    __device__ __forceinline__ bool next(int i, Unit& u) const { const int L = i * G + c; const int nblk = (int)tab[0]; if (L >= nblk * npn) return false; u.pm = L / npn; u.pn = L - u.pm * npn; u.kind = (int)tab[40 + u.pm]; return true; }
    __device__ __forceinline__ const char* a_ptr(const Unit& u) const { return a + (size_t)u.pm * astep; }
    __device__ __forceinline__ const char* b_ptr(const Unit& u) const { return b + (size_t)(u.kind * npn + u.pn) * bstep; }
    __device__ __forceinline__ int nt(const Unit&) const { return ntk; }
    __device__ __forceinline__ bool keep(const Unit&) const { return false; }
    const unsigned* list;
    __device__ __forceinline__ unsigned goff(const Unit& u, int r) const { const unsigned e = (unsigned)u.kind, pos = ((unsigned)u.pm - tab[1 + e]) * 256u + (unsigned)r;
        return (pos < tab[340 + e] ? list[(size_t)e * ML + pos] : (unsigned)ML) * (unsigned)(D * 2); }
};
constexpr int CW_PUB = 24576;
struct SchedMoeDown {
    const char* a; const char* b; int G, c; volatile LAS unsigned* tab; unsigned* pub;
    __device__ __forceinline__ bool next(int i, Unit& u) const {
        const int nblk = (int)tab[0]; const int G4 = G >> 2, q15 = (4 * nblk) / G, r = (4 * nblk) - q15 * G, r4 = r >> 2, nl = G - r, nlb = G4 - r4, NLU = 8 * q15 * nlb;
        int P;
        if (c >= r) P = (i < 4) ? i * nl + (c - r) : 4 * nl + (i - 4) * G + c; else P = 4 * nl + i * G + c;
        if (P >= nblk * 8) return false;
        u.pn = P & 7;
        if (P < NLU) { const int lb = P >> 3, g = lb / nlb; u.pm = g * G4 + (lb - g * nlb) + r4; }
        else { const int hb = (P - NLU) >> 3, g = hb / (r4 > 0 ? r4 : 1); u.pm = g * G4 + (hb - g * r4); }
        u.kind = (int)tab[40 + u.pm];
        if (threadIdx.x < 64) {
            if (tab[380] == 0u) {
                const int pl = (int)(threadIdx.x & 63u);
                const unsigned* fp = pl < 4 ? pub + 64 * ((4 * u.pm + pl) % G) : pub + 64 * 300;
                unsigned sp = 0, fv;
                for (;;) { fv = __hip_atomic_load(fp, RLX_AGENT); if (__builtin_amdgcn_ballot_w64(pl < 4 && fv == 0u) == 0ull) break; __builtin_amdgcn_s_sleep(2); if (++sp > (1u << 22)) break; }
                const unsigned gd = (unsigned)__builtin_amdgcn_readlane((int)fv, 4);
                __builtin_amdgcn_fence(__ATOMIC_ACQUIRE, "agent");
                asm volatile("s_waitcnt vmcnt(0)" ::: "memory");
                if (gd >= (unsigned)G && threadIdx.x == 0) tab[380] = 1u;
            }
        }
        asm volatile("" ::: "memory"); __builtin_amdgcn_s_barrier(); asm volatile("" ::: "memory");
        return true;
    }
    __device__ __forceinline__ const char* a_ptr(const Unit& u) const { return a + (size_t)u.pm * 256 * 512 * 2; }
    __device__ __forceinline__ const char* b_ptr(const Unit& u) const { return b + (size_t)(u.kind * 8 + u.pn) * 256 * 512 * 2; }
    __device__ __forceinline__ int nt(const Unit&) const { return 8; }
    __device__ __forceinline__ bool keep(const Unit&) const { return false; }
};
struct EpiMoe1 {
    bf16* H;
    __device__ __forceinline__ void operator()(const f32x4 (&acc)[2][2][4][2], const Unit& u, int wr, int wc, int fr, int fq) const {
        const int row0 = u.pm * 256 + wr * 64 + fr, col0 = u.pn * 128 + wc * 32 + 8 * fq;
#pragma unroll
        for (int ai = 0; ai < 2; ++ai)
#pragma unroll
            for (int m = 0; m < 4; ++m) { const f32x4 a0 = acc[ai][0][m][0], a1 = acc[ai][0][m][1], b0 = acc[ai][1][m][0], b1 = acc[ai][1][m][1];
                float v[8];
#pragma unroll
                for (int q = 0; q < 4; ++q) { v[q] = a0[q] * sigmoidf_(a0[q]) * b0[q]; v[4 + q] = a1[q] * sigmoidf_(a1[q]) * b1[q]; }
                v4u w; w.x = cvt_pk_bf16(v[0], v[1]); w.y = cvt_pk_bf16(v[2], v[3]); w.z = cvt_pk_bf16(v[4], v[5]); w.w = cvt_pk_bf16(v[6], v[7]);
                *(v4u*)(H + (size_t)(row0 + ai * 128 + m * 16) * DE + col0) = w; }
    }
};
struct EpiMoe2 {
    bf16* Y;
    __device__ __forceinline__ void operator()(const f32x4 (&acc)[2][2][4][2], const Unit& u, int wr, int wc, int fr, int fq) const {
        const int row0 = u.pm * 256 + wr * 64 + fr, col0 = u.pn * 256 + wc * 32 + 8 * fq;
#pragma unroll
        for (int ai = 0; ai < 2; ++ai)
#pragma unroll
            for (int m = 0; m < 4; ++m)
#pragma unroll
                for (int bj = 0; bj < 2; ++bj) { const f32x4 v0 = acc[ai][bj][m][0], v1 = acc[ai][bj][m][1];
                    v4u w; w.x = cvt_pk_bf16(v0[0], v0[1]); w.y = cvt_pk_bf16(v0[2], v0[3]); w.z = cvt_pk_bf16(v1[0], v1[1]); w.w = cvt_pk_bf16(v1[2], v1[3]);
                    *(v4u*)(Y + (size_t)(row0 + ai * 128 + m * 16) * D + col0 + bj * 128) = w; }
    }
};

__device__ __forceinline__ void phase_final(const Frame& F, const Args& A, const int pr = 0) {
    build_block_table(F);
    volatile LAS unsigned* tab = (volatile LAS unsigned*)(F.lds + LDSCTL_OFF);
    const float* sm = (const float*)(F.ws + WS_SMALL);
    const bf16* Y = (const bf16*)(F.ws + WS_XG);
    const unsigned* tokrec = (const unsigned*)(F.ws + WS_TOK);
    for (int m = F.gw; m < ML; m += F.ngw) {
        const int b = m / T; const float* gt2 = sm + SM_MOD + b * 12288 + 5 * 2048;
        const v4u rec = *(const GAS v4u*)(tokrec + (size_t)m * 4);
        const unsigned e0 = rec.x & 0xffu, e1 = (rec.x >> 8) & 0xffu;
        const unsigned s0 = tab[1 + e0] * 256u + (rec.y & 0xffffu), s1 = tab[1 + e1] * 256u + (rec.y >> 16);
        const float g0 = __uint_as_float(rec.z), g1 = __uint_as_float(rec.w);
        GAS f32x4* o = (GAS f32x4*)(A.out + (size_t)m * D) + F.lane; const GAS v2u* xn = (const GAS v2u*)((const unsigned short*)(F.ws + WS_XN) + (size_t)m * D) + F.lane;
        const GAS v2u* y0 = (const GAS v2u*)(Y + (size_t)s0 * D) + F.lane; const GAS v2u* y1 = (const GAS v2u*)(Y + (size_t)s1 * D) + F.lane;
#pragma unroll
        for (int q = 0; q < 8; ++q) { const int c = 4 * F.lane + 256 * q; const f32x4 g = *(const f32x4*)(gt2 + c);
            const v2u a = y0[64 * q], bb = y1[64 * q]; const v2u xh = xn[64 * q]; const f32x4 x = {f16lo(xh.x), f16hi(xh.x), f16lo(xh.y), f16hi(xh.y)};
            const f32x4 mo = {g0 * bf2f(a.x & 0xffffu) + g1 * bf2f(bb.x & 0xffffu), g0 * bf2f(a.x >> 16) + g1 * bf2f(bb.x >> 16), g0 * bf2f(a.y & 0xffffu) + g1 * bf2f(bb.y & 0xffffu), g0 * bf2f(a.y >> 16) + g1 * bf2f(bb.y >> 16)};
            o[64 * q] = x + g * mo; }
    }
}

#ifndef DUPK
#define DUPK -1
#endif
constexpr int NPHASE = 17;
constexpr int REPS[18] = {1, 1, 1, 1, 1, 1, 1, 1, 1, 1, 1, 1, 1, 1, 1, 1, 1, 1};
__global__ void __launch_bounds__(512, 2) mk_fwd(Args args) {
    extern __shared__ __attribute__((aligned(16))) unsigned char lds_raw[];
    Frame F;
    F.lds = (LAS unsigned char*)lds_raw; F.ws = args.ws;
    F.tid = threadIdx.x; F.lane = F.tid & 63; F.wave = __builtin_amdgcn_readfirstlane(F.tid >> 6);
    F.G = gridDim.x; F.bid = blockIdx.x; F.gw = F.bid * 8 + F.wave; F.ngw = F.G * 8;
    for (int u = F.tid; u < (LDS_BYTES - LDSCTL_OFF) / 4; u += 512) ((LAS unsigned*)(F.lds + LDSCTL_OFF))[u] = 0u;
    __syncthreads();
    unsigned* ctl = (unsigned*)(F.ws + WS_CTL);
    XcdBarrier bar; bar.bar = ctl + CW_BAR; bar.x = 0; bar.st = nullptr;
#if !MK_PER_PHASE
    bar = xcd_barrier_post(ctl + CW_BAR, (volatile LAS unsigned*)(F.lds + MISC_OFF));
#endif
    const int lo = args.ph_lo, hi = args.ph_hi;
#ifndef PH_ENABLE
#define PH_ENABLE 0xFFFFFFFFu
#endif
#define IN(k) (((PH_ENABLE >> (k)) & 1u) && lo <= (k) && (k) < hi)
#if MK_PER_PHASE
#define SEAM(k) do { } while (0)
#else
#define SEAM(k) do { if (IN(k) && IN((k) + 1)) xcd_barrier(bar); } while (0)
#endif
    LAS unsigned char* ring = F.lds;
    if (IN(0)) { for (int rep_ = 0; rep_ < REPS[0]; ++rep_) { if (rep_) xcd_barrier(bar); phase_prologue(F, args); } }
    if (IN(0) && IN(1)) {
        if (F.tid < 64) { const unsigned* mp = (const unsigned*)(F.ws + WS_CTL) + CW_MODPUB; unsigned sp = 0;
            while ((unsigned)__builtin_amdgcn_readfirstlane((int)__hip_atomic_load(mp, __ATOMIC_RELAXED, __HIP_MEMORY_SCOPE_AGENT)) < (unsigned)F.G) { __builtin_amdgcn_s_sleep(2); if (++sp > (1u << 24)) break; }
            __builtin_amdgcn_fence(__ATOMIC_ACQUIRE, "agent"); asm volatile("s_waitcnt vmcnt(0)" ::: "memory"); }
        __syncthreads();
    }
    if (IN(1)) { for (int rep_ = 0; rep_ < REPS[1]; ++rep_) { if (rep_) xcd_barrier(bar); phase_hx<true>(F, args, (bf16*)(F.ws + WS_HX)); } } SEAM(1);
    if (IN(2)) { for (int rep_ = 0; rep_ < REPS[2]; ++rep_) { if (rep_) xcd_barrier(bar); SchedInproj S{(const char*)(F.ws + WS_HX), (const char*)(F.ws + WS_W1T), (const char*)(F.ws + WS_WVT), F.G, F.bid};
        EpiInproj E{(bf16*)(F.ws + WS_P1), (bf16*)(F.ws + WS_VT)};
        pg8::gemm_phase<EpiInproj, SchedInproj>(ring, 2048, 2048, S, E); } } SEAM(2);
    if (IN(3)) { phase_e1(F, args);
#if DUPK == 3
        xcd_barrier(bar); phase_e1(F, args, 1);
#endif
    } SEAM(3);
    if (IN(4)) { { SchedLora S{(const char*)(F.ws + WS_XL), (const char*)(F.ws + WS_LW), F.G, F.bid};
        EpiLora E{(unsigned short*)(F.ws + WS_LO), (bf16*)(F.ws + WS_G), args.in[10], args.in[12]};
        pg8::gemm_phase<EpiLora, SchedLora>(ring, XLLD, 256, S, E); }
#if DUPK == 4
        xcd_barrier(bar); { SchedLora S{(const char*)(F.ws + WS_XL), (const char*)(F.ws + WS_LW), F.G, F.bid};
        EpiLora E{(unsigned short*)(F.ws + WS_LO), (bf16*)(F.ws + WS_G), args.in[10], args.in[12]};
        pg8::gemm_phase<EpiLora, SchedLora>(ring, XLLD, 256, S, E); }
#endif
    } SEAM(4);
    if (IN(5)) { phase_scan(F, args);
        if (((const float*)(F.ws + WS_SMALL))[SM_MISC + 1] < 100.0f) phase_attn2(F, args);
        else { phase_attn(F, args); LAS float* scr = (LAS float*)(F.lds + F.wave * 16640); for (int it = F.gw; it < LW_NIT; it += F.ngw) latew_item(F, args, it, scr, F.lane); }
        phase_rcomb(F, args, 0, 1);
    } SEAM(5);
    const float* smod = (const float*)(F.ws + WS_SMALL) + SM_MOD;
    if (IN(9)) { for (int rep_ = 0; rep_ < REPS[9]; ++rep_) { if (rep_) xcd_barrier(bar); SchedGates S{(const char*)(F.ws + WS_HX), (const char*)(F.ws + WS_WGT), F.G, F.bid};
        EpiMerge<0> E{(bf16*)(F.ws + WS_GATE), (bf16*)(F.ws + WS_MIX), args.in[0], args.out, smod};
        pg8::gemm_phase<EpiMerge<0>, SchedGates>(ring, 2048, 2048, S, E); } }
    asm volatile("s_waitcnt vmcnt(0)" ::: "memory"); __syncthreads();
    if (IN(10)) { SchedMerge2 S{(const char*)args.out + OUT_YF, (const char*)(F.ws + WS_YD), (const char*)(F.ws + WS_WPA), (const char*)(F.ws + WS_WPB), F.G, F.bid};
        EpiMerge12 E{(const bf16*)(F.ws + WS_GATE), (bf16*)(F.ws + WS_MIX)};
        pg8::gemm_phase<EpiMerge12, SchedMerge2>(ring, 1024, 1024, S, E); } SEAM(10);
    if (IN(12)) { for (int rep_ = 0; rep_ < REPS[12]; ++rep_) { if (rep_) xcd_barrier(bar); SchedSimple S{(const char*)(F.ws + WS_MIX), (const char*)(F.ws + WS_WOUT), (size_t)256 * 2048 * 2, (size_t)256 * 2048 * 2, 128, 8, 32, F.G, F.bid};
        EpiMerge<3> E{(bf16*)(F.ws + WS_GATE), (bf16*)(F.ws + WS_MIX), args.in[0], (float*)(F.ws + WS_XN), smod};
        pg8::gemm_phase<EpiMerge<3>, SchedSimple>(ring, 2048, 2048, S, E); } } SEAM(12);
    if (IN(13)) { phase_router2(F, args);
#if DUPK == 13
        xcd_barrier(bar); phase_router2(F, args, 1);
#endif
    } SEAM(13);
    if (IN(15)) { build_block_table(F);
        { SchedMoe S{(const char*)(F.ws + WS_H2), (const char*)args.out + OUT_EW13, (size_t)0, (size_t)256 * 2048 * 2, 4, 32, F.G, F.bid, (volatile LAS unsigned*)(F.lds + LDSCTL_OFF), (const unsigned*)(F.ws + WS_GOFF)};
          EpiMoe1 E{(bf16*)(F.ws + WS_HM)};
          pg8::gemm_phase<EpiMoe1, SchedMoe, true>(ring, 2048, 2048, S, E); }
        asm volatile("s_waitcnt vmcnt(0) lgkmcnt(0)" ::: "memory"); __syncthreads();
        if (F.tid == 0) { unsigned* pub = (unsigned*)(F.ws + WS_CTL) + CW_PUB;
            __builtin_amdgcn_fence(__ATOMIC_RELEASE, "agent"); asm volatile("s_waitcnt vmcnt(0)" ::: "memory");
            (void)__hip_atomic_fetch_add(pub + 64 * F.bid, 1u, RLX_AGENT); (void)__hip_atomic_fetch_add(pub + 64 * 300, 1u, RLX_AGENT);
            ((volatile LAS unsigned*)(F.lds + LDSCTL_OFF))[380] = 0u; }
        __syncthreads();
        { SchedMoeDown S{(const char*)(F.ws + WS_HM), (const char*)args.out + OUT_EW2, F.G, F.bid, (volatile LAS unsigned*)(F.lds + LDSCTL_OFF), (unsigned*)(F.ws + WS_CTL) + CW_PUB};
          EpiMoe2 E{(bf16*)(F.ws + WS_XG)};
          pg8::gemm_phase<EpiMoe2, SchedMoeDown>(ring, 512, 512, S, E); }
    } SEAM(15);
    if (IN(17)) { phase_final(F, args);
#if DUPK == 17
        xcd_barrier(bar); phase_final(F, args, 1);
#endif
    }
#undef IN
#undef SEAM
}

extern "C" void kernel_launch(void* const* d_in, const int* in_sizes, int n_in, void* d_out, int out_size, void* d_ws, size_t ws_size, hipStream_t stream) {
    static int grid = 0;
    if (grid == 0) {
        if (n_in != 34 || out_size != ML * D || ws_size < WS_NEED) { fprintf(stderr, "kernel_launch: unexpected problem (n_in %d out %d ws %zu)\n", n_in, out_size, ws_size); grid = -1; return; }
        int dev = 0, cus = 0, per_cu = 0;
        if (hipGetDevice(&dev) != hipSuccess || hipDeviceGetAttribute(&cus, hipDeviceAttributeMultiprocessorCount, dev) != hipSuccess) { grid = -1; return; }
        if (hipFuncSetAttribute((const void*)mk_fwd, hipFuncAttributeMaxDynamicSharedMemorySize, LDS_BYTES) != hipSuccess) { fprintf(stderr, "kernel_launch: hipFuncSetAttribute failed\n"); grid = -1; return; }
        if (hipOccupancyMaxActiveBlocksPerMultiprocessor(&per_cu, (const void*)mk_fwd, 512, LDS_BYTES) != hipSuccess || per_cu < 1) fprintf(stderr, "kernel_launch: occupancy query says %d\n", per_cu);
        (void)hipGetLastError();
        grid = cus;
    }
    if (grid < 0) return;
    if (hipMemsetAsync((char*)d_ws + WS_CTL, 0, CTL_ZERO_BYTES, stream) != hipSuccess) return;
    Args a{};
    for (int i = 0; i < 34; ++i) a.in[i] = (const float*)d_in[i];
    a.out = (float*)d_out; a.ws = (unsigned char*)d_ws;
#if MK_PER_PHASE
    for (int p = 0; p <= NPHASE; ++p) { a.ph_lo = p; a.ph_hi = p + 1; hipLaunchKernelGGL(mk_fwd, dim3(grid), dim3(512), LDS_BYTES, stream, a); }
#else
    a.ph_lo = 0; a.ph_hi = NPHASE + 1;
    hipLaunchKernelGGL(mk_fwd, dim3(grid), dim3(512), LDS_BYTES, stream, a);
#endif
}
```
